# Optimizing an MI355X kernel written in HIP

```python
import jax
import jax.numpy as jnp
from jax import lax
import numpy as np

D_MODEL = 2048
BATCH = 4
SEQ = 4096
DEPTH = 1

CTX_LEN = 256
GRID_W = 64
EPS = 1e-6

GLA_HEADS = 4
GLA_DK = 256
GLA_DV = 512
GLA_LOWRANK = 16
GLA_TAU = 16.0
GLA_CHUNK = 64
GLA_QK_W = GLA_HEADS * GLA_DK
GLA_V_W = GLA_HEADS * GLA_DV

MLA_HEADS = 16
MLA_Q_RANK = 512
MLA_KV_RANK = 512
MLA_NOPE = 128
MLA_ROPE = 64
MLA_V = 128
MLA_QK_DIM = MLA_NOPE + MLA_ROPE
MLA_OUT_W = MLA_HEADS * MLA_V
ROPE_THETA = 10000.0
Q_BLOCK = 128

N_GROUPS = 8
EXP_PER_GROUP = 8
N_EXPERTS = N_GROUPS * EXP_PER_GROUP
TOP_K_IN_GROUP = 2
D_EXPERT = 512
DISPATCH_BLOCK = 128

IN_SPLITS = (GLA_QK_W, GLA_QK_W, GLA_V_W, GLA_V_W, GLA_LOWRANK, GLA_LOWRANK,
             MLA_Q_RANK, MLA_KV_RANK, MLA_ROPE, D_MODEL, D_MODEL)
D_IN = 2 * GLA_QK_W + 2 * GLA_V_W + 2 * GLA_LOWRANK + MLA_Q_RANK + MLA_KV_RANK + MLA_ROPE + 2 * D_MODEL

kernel_name = 'hybrid_gla_mla_hmoe_dit_block'


def rmsnorm(x, g):
    xf = x.astype(jnp.float32)
    y = xf * lax.rsqrt(jnp.mean(xf * xf, axis=-1, keepdims=True) + EPS)
    return (y * g.astype(jnp.float32)).astype(x.dtype)


def modulate(x, g, shift, scale):
    return rmsnorm(x, g) * (1 + scale) + shift


def split_heads(x, n):
    b, l, _ = x.shape
    return x.reshape(b, l, n, -1).transpose(0, 2, 1, 3)


def merge_heads(x):
    b, h, l, d = x.shape
    return x.transpose(0, 2, 1, 3).reshape(b, l, h * d)


def flip_seq(t):
    return jnp.flip(t, axis=2)


def split_in(p):
    offsets = np.cumsum(IN_SPLITS)[:-1].tolist()
    return jnp.split(p, offsets, axis=-1)


def axial_angles(length):
    rows = length // GRID_W
    row = jnp.repeat(jnp.arange(rows), GRID_W).astype(jnp.float32)
    col = jnp.tile(jnp.arange(GRID_W), rows).astype(jnp.float32)
    n_freq = MLA_ROPE // 4
    inv = 1.0 / (ROPE_THETA ** (jnp.arange(n_freq, dtype=jnp.float32) / n_freq))
    return row[:, None] * inv, col[:, None] * inv


def rope_half(x, ang):
    half = x.shape[-1] // 2
    cos = jnp.cos(ang).astype(x.dtype)
    sin = jnp.sin(ang).astype(x.dtype)
    x1, x2 = x[..., :half], x[..., half:]
    return jnp.concatenate([x1 * cos - x2 * sin, x1 * sin + x2 * cos], axis=-1)


def rope_tail_2d(x, angles):
    ang_r, ang_c = angles
    half = MLA_ROPE // 2
    x_nope = x[..., :MLA_NOPE]
    x_row = x[..., MLA_NOPE:MLA_NOPE + half]
    x_col = x[..., MLA_NOPE + half:]
    return jnp.concatenate([x_nope, rope_half(x_row, ang_r), rope_half(x_col, ang_c)], axis=-1)


def to_heads_f32(t, n):
    return split_heads(t, n).astype(jnp.float32)


def gla_log_decay(a_low, w2, b2):
    z = (a_low @ w2 + b2).astype(jnp.float32)
    return split_heads(jax.nn.log_sigmoid(z) / GLA_TAU, GLA_HEADS)


def gla_chunked(q, k, v, g, s0):
    b_, h_, l_, dk = q.shape
    dv = v.shape[-1]
    n = l_ // GLA_CHUNK
    q, k, g = (a.reshape(b_, h_, n, GLA_CHUNK, dk) for a in (q, k, g))
    v = v.reshape(b_, h_, n, GLA_CHUNK, dv)
    bc = jnp.cumsum(g, axis=3)
    b_end = bc[:, :, :, -1:, :]
    q_dec = q * jnp.exp(bc)
    k_inv = k * jnp.exp(-bc)
    k_to_end = k * jnp.exp(b_end - bc)
    mask = jnp.tril(jnp.ones((GLA_CHUNK, GLA_CHUNK), dtype=bool))
    att = jnp.where(mask, jnp.einsum('bhnid,bhnjd->bhnij', q_dec, k_inv), 0.0)
    o_intra = jnp.einsum('bhnij,bhnje->bhnie', att, v)

    def step(state, xs):
        qd, ke, vc, de = xs
        o = jnp.einsum('bhid,bhde->bhie', qd, state)
        state = state * de[..., None] + jnp.einsum('bhjd,bhje->bhde', ke, vc)
        return state, o

    xs = tuple(jnp.moveaxis(t, 2, 0) for t in (q_dec, k_to_end, v, jnp.exp(b_end[:, :, :, 0, :])))
    s_end, o_inter = lax.scan(step, s0, xs)
    o = o_intra + jnp.moveaxis(o_inter, 0, 2)
    return o.reshape(b_, h_, l_, dv), s_end


def gla_final_state(k, v, g):
    bc = jnp.cumsum(g, axis=2)
    return jnp.einsum('bhld,bhle->bhde', k * jnp.exp(bc[:, :, -1:, :] - bc), v)


def gla_readout(o, norm_g, r):
    return merge_heads(rmsnorm(o, norm_g)).astype(r.dtype) * jax.nn.silu(r)


def mla_queries(cq, qa_g, w_uq, qn_g, angles):
    q = split_heads(rmsnorm(cq, qa_g) @ w_uq, MLA_HEADS)
    q = rmsnorm(q, qn_g)
    return q if angles is None else rope_tail_2d(q, angles)


def mla_keys_values(ckv, kr, kva_g, w_ukv, kn_g, angles):
    kv = split_heads(rmsnorm(ckv, kva_g) @ w_ukv, MLA_HEADS)
    k_nope, v = kv[..., :MLA_NOPE], kv[..., MLA_NOPE:]
    b_, h_, l_, _ = k_nope.shape
    k_rope = jnp.broadcast_to(kr[:, None, :, :], (b_, h_, l_, MLA_ROPE))
    k = rmsnorm(jnp.concatenate([k_nope, k_rope], axis=-1), kn_g)
    return (k if angles is None else rope_tail_2d(k, angles)), v


def softmax_attention(q, k, v):
    s = jnp.einsum('bhqd,bhkd->bhqk', q, k).astype(jnp.float32) * (MLA_QK_DIM ** -0.5)
    p = jax.nn.softmax(s, axis=-1).astype(v.dtype)
    return jnp.einsum('bhqk,bhkd->bhqd', p, v)


def blockwise_attention(q, k, v):
    b_, h_, l_, d_ = q.shape
    nb = l_ // Q_BLOCK
    qb = q.reshape(b_, h_, nb, Q_BLOCK, d_).transpose(2, 0, 1, 3, 4)
    ob = lax.map(lambda qi: softmax_attention(qi, k, v), qb)
    return ob.transpose(1, 2, 0, 3, 4).reshape(b_, h_, l_, v.shape[-1])


def branch_merge(y_gla, y_mla, gate_gla, gate_mla, w_o_gla, w_o_mla, w_out):
    y = jax.nn.sigmoid(gate_gla) * (y_gla @ w_o_gla) + jax.nn.sigmoid(gate_mla) * (y_mla @ w_o_mla)
    return y @ w_out


def hierarchical_moe(h, w_rg, b_rg, w_re, b_re, w_gate, w_up, w_down):
    b_, l_, d_ = h.shape
    t = b_ * l_
    hf = h.reshape(t, d_)
    p_grp = jax.nn.softmax((hf @ w_rg + b_rg).astype(jnp.float32), axis=-1)
    p_g, g_idx = lax.top_k(p_grp, 1)
    logit_e = (hf @ w_re + b_re).astype(jnp.float32).reshape(t, N_GROUPS, EXP_PER_GROUP)
    logit_e = jnp.take_along_axis(logit_e, g_idx[:, :, None], axis=1)[:, 0, :]
    p_e, e_idx = lax.top_k(jax.nn.softmax(logit_e, axis=-1), TOP_K_IN_GROUP)
    wts = (p_g * p_e / jnp.sum(p_e, axis=-1, keepdims=True)).reshape(-1)
    eid = (g_idx * EXP_PER_GROUP + e_idx).reshape(-1)
    n_assign = t * TOP_K_IN_GROUP
    tok = jnp.repeat(jnp.arange(t, dtype=jnp.int32), TOP_K_IN_GROUP)
    order = jnp.argsort(eid)
    e_s, tok_s, w_s = eid[order], tok[order], wts[order]
    counts = jnp.zeros((N_EXPERTS,), jnp.int32).at[eid].add(1)
    start = jnp.cumsum(counts) - counts
    padded = (counts + DISPATCH_BLOCK - 1) // DISPATCH_BLOCK * DISPATCH_BLOCK
    pend = jnp.cumsum(padded)
    pstart = pend - padded
    dest = pstart[e_s] + jnp.arange(n_assign, dtype=jnp.int32) - start[e_s]
    n_blocks = (n_assign + DISPATCH_BLOCK - 1) // DISPATCH_BLOCK + N_EXPERTS
    slot_tok = jnp.full((n_blocks * DISPATCH_BLOCK,), t, jnp.int32).at[dest].set(tok_s)
    slot_w = jnp.zeros((n_blocks * DISPATCH_BLOCK,), h.dtype).at[dest].set(w_s.astype(h.dtype))
    block_e = jnp.minimum(
        jnp.searchsorted(pend, jnp.arange(n_blocks, dtype=jnp.int32) * DISPATCH_BLOCK, side='right'),
        N_EXPERTS - 1)
    h_pad = jnp.concatenate([hf, jnp.zeros((1, d_), h.dtype)], axis=0)

    def expert_block(args):
        idx, w, e = args
        xb = h_pad[idx]
        y = (jax.nn.silu(xb @ w_gate[e]) * (xb @ w_up[e])) @ w_down[e]
        return y * w[:, None]

    y = lax.map(expert_block, (slot_tok.reshape(n_blocks, DISPATCH_BLOCK),
                               slot_w.reshape(n_blocks, DISPATCH_BLOCK), block_e))
    out = jnp.zeros((t + 1, d_), h.dtype).at[slot_tok].add(y.reshape(-1, d_))
    return out[:t].reshape(b_, l_, d_)


def setup_inputs(seed: int = 0) -> dict:
    key = jax.random.key(seed)
    ks = jax.random.split(key, 32)
    d = D_MODEL

    def nrm(k, shape, scale):
        return jax.random.normal(k, shape, jnp.float32) * scale

    def gain(k, n):
        return 1.0 + nrm(k, (DEPTH, n), 0.02)

    return {
        'x': nrm(ks[0], (BATCH, SEQ, d), 1.0),
        'c': nrm(ks[1], (BATCH, d), 1.0),
        'ctx': nrm(ks[2], (BATCH, CTX_LEN, d), 1.0),
        'c_ctx': nrm(ks[3], (d,), 1.0),
        'w_mod': nrm(ks[4], (DEPTH, d, 6 * d), 0.5 * d ** -0.5),
        'b_mod': nrm(ks[5], (DEPTH, 6 * d), 0.02),
        'norm1_g': gain(ks[6], d),
        'norm2_g': gain(ks[7], d),
        'w_in': nrm(ks[8], (DEPTH, d, D_IN), d ** -0.5),
        'w_decay_f': nrm(ks[9], (DEPTH, GLA_LOWRANK, GLA_QK_W), GLA_LOWRANK ** -0.5),
        'b_decay_f': nrm(ks[10], (DEPTH, GLA_QK_W), 0.1),
        'w_decay_b': nrm(ks[11], (DEPTH, GLA_LOWRANK, GLA_QK_W), GLA_LOWRANK ** -0.5),
        'b_decay_b': nrm(ks[12], (DEPTH, GLA_QK_W), 0.1),
        'gla_norm_g': gain(ks[13], GLA_DV),
        'q_a_norm_g': gain(ks[14], MLA_Q_RANK),
        'w_uq': nrm(ks[15], (DEPTH, MLA_Q_RANK, MLA_HEADS * MLA_QK_DIM), MLA_Q_RANK ** -0.5),
        'kv_a_norm_g': gain(ks[16], MLA_KV_RANK),
        'w_ukv': nrm(ks[17], (DEPTH, MLA_KV_RANK, MLA_HEADS * (MLA_NOPE + MLA_V)), MLA_KV_RANK ** -0.5),
        'q_norm_g': gain(ks[18], MLA_QK_DIM),
        'k_norm_g': gain(ks[19], MLA_QK_DIM),
        'w_o_gla': nrm(ks[20], (DEPTH, GLA_V_W, d), GLA_V_W ** -0.5),
        'w_o_mla': nrm(ks[21], (DEPTH, MLA_OUT_W, d), MLA_OUT_W ** -0.5),
        'w_out': nrm(ks[22], (DEPTH, d, d), d ** -0.5),
        'w_router_group': nrm(ks[23], (DEPTH, d, N_GROUPS), d ** -0.5),
        'b_router_group': nrm(ks[24], (DEPTH, N_GROUPS), 0.01),
        'w_router_expert': nrm(ks[25], (DEPTH, d, N_EXPERTS), d ** -0.5),
        'b_router_expert': nrm(ks[26], (DEPTH, N_EXPERTS), 0.01),
        'w_exp_gate': nrm(ks[27], (DEPTH, N_EXPERTS, d, D_EXPERT), d ** -0.5),
        'w_exp_up': nrm(ks[28], (DEPTH, N_EXPERTS, d, D_EXPERT), d ** -0.5),
        'w_exp_down': nrm(ks[29], (DEPTH, N_EXPERTS, D_EXPERT, d), D_EXPERT ** -0.5),
    }


def reference(x, c, ctx, c_ctx, w_mod, b_mod, norm1_g, norm2_g, w_in,
              w_decay_f, b_decay_f, w_decay_b, b_decay_b, gla_norm_g,
              q_a_norm_g, w_uq, kv_a_norm_g, w_ukv, q_norm_g, k_norm_g,
              w_o_gla, w_o_mla, w_out,
              w_router_group, b_router_group, w_router_expert, b_router_expert,
              w_exp_gate, w_exp_up, w_exp_down):
    angles = axial_angles(x.shape[1])
    for l in range(DEPTH):
        update_ctx = l < DEPTH - 1
        sh1, sc1, gt1, sh2, sc2, gt2 = jnp.split(
            (jax.nn.silu(c) @ w_mod[l] + b_mod[l])[:, None, :], 6, axis=-1)
        sh1c, sc1c, gt1c, sh2c, sc2c, gt2c = jnp.split(
            (jax.nn.silu(c_ctx) @ w_mod[l] + b_mod[l])[None, None, :], 6, axis=-1)

        h = modulate(x, norm1_g[l], sh1, sc1)
        hc = modulate(ctx, norm1_g[l], sh1c, sc1c)
        qg, kg, vg, rg, af, ab, cq, ckv, kr, ga, gb = split_in(h @ w_in[l])
        qgc, kgc, vgc, rgc, afc, abc, cqc, ckvc, krc, gac, gbc = split_in(hc @ w_in[l])

        q = to_heads_f32(qg, GLA_HEADS) * GLA_DK ** -0.5
        k = to_heads_f32(kg, GLA_HEADS)
        v = to_heads_f32(vg, GLA_HEADS)
        g_f = gla_log_decay(af, w_decay_f[l], b_decay_f[l])
        g_b = gla_log_decay(ab, w_decay_b[l], b_decay_b[l])
        kc = to_heads_f32(kgc, GLA_HEADS)
        vc = to_heads_f32(vgc, GLA_HEADS)
        gc_f = gla_log_decay(afc, w_decay_f[l], b_decay_f[l])
        gc_b = gla_log_decay(abc, w_decay_b[l], b_decay_b[l])
        if update_ctx:
            qc = to_heads_f32(qgc, GLA_HEADS) * GLA_DK ** -0.5
            zero = jnp.zeros(kc.shape[:2] + (GLA_DK, GLA_DV), jnp.float32)
            oc_f, s_f = gla_chunked(qc, kc, vc, gc_f, zero)
            oc_b, s_b = gla_chunked(flip_seq(qc), flip_seq(kc), flip_seq(vc), flip_seq(gc_b), zero)
            oc_gla = oc_f + flip_seq(oc_b)
        else:
            s_f = gla_final_state(kc, vc, gc_f)
            s_b = gla_final_state(flip_seq(kc), flip_seq(vc), flip_seq(gc_b))
        o_f, _ = gla_chunked(q, k, v, g_f, s_f)
        o_b, _ = gla_chunked(flip_seq(q), flip_seq(k), flip_seq(v), flip_seq(g_b), s_b)
        y_gla = gla_readout(o_f + flip_seq(o_b), gla_norm_g[l], rg)

        q_m = mla_queries(cq, q_a_norm_g[l], w_uq[l], q_norm_g[l], angles)
        k_m, v_m = mla_keys_values(ckv, kr, kv_a_norm_g[l], w_ukv[l], k_norm_g[l], angles)
        k_mc, v_mc = mla_keys_values(ckvc, krc, kv_a_norm_g[l], w_ukv[l], k_norm_g[l], None)
        y_mla = merge_heads(blockwise_attention(
            q_m, jnp.concatenate([k_m, k_mc], axis=2), jnp.concatenate([v_m, v_mc], axis=2)))

        if update_ctx:
            q_mc = mla_queries(cqc, q_a_norm_g[l], w_uq[l], q_norm_g[l], None)
            yc_mla = merge_heads(softmax_attention(q_mc, k_mc, v_mc))
            yc_gla = gla_readout(oc_gla, gla_norm_g[l], rgc)
            ctx = ctx + gt1c * branch_merge(yc_gla, yc_mla, gac, gbc, w_o_gla[l], w_o_mla[l], w_out[l])
            ctx = ctx + gt2c * hierarchical_moe(
                modulate(ctx, norm2_g[l], sh2c, sc2c), w_router_group[l], b_router_group[l],
                w_router_expert[l], b_router_expert[l], w_exp_gate[l], w_exp_up[l], w_exp_down[l])

        x = x + gt1 * branch_merge(y_gla, y_mla, ga, gb, w_o_gla[l], w_o_mla[l], w_out[l])
        x = x + gt2 * hierarchical_moe(
            modulate(x, norm2_g[l], sh2, sc2), w_router_group[l], b_router_group[l],
            w_router_expert[l], b_router_expert[l], w_exp_gate[l], w_exp_up[l], w_exp_down[l])
    return x
```

```cpp
#include <hip/hip_runtime.h>
#include <cstdio>
#include <cstdint>

#define LAS __attribute__((address_space(3)))
#define GAS __attribute__((address_space(1)))
typedef unsigned short bf16_t;
typedef short bf16x8 __attribute__((ext_vector_type(8)));
typedef short s16x4 __attribute__((ext_vector_type(4)));
typedef float f32x2 __attribute__((ext_vector_type(2)));
typedef float f32x4 __attribute__((ext_vector_type(4)));
typedef float f32x16 __attribute__((ext_vector_type(16)));
typedef unsigned u32x2 __attribute__((ext_vector_type(2)));
typedef unsigned u32x4 __attribute__((ext_vector_type(4)));

constexpr int DM = 2048, NB = 4, SEQ = 4096, CTXL = 256;
constexpr int TL = NB * SEQ;
constexpr int TCX = NB * CTXL;
constexpr int TA = TL + TCX;
constexpr int D_IN = 11360, N_INP = 11520;
constexpr int NKEY = SEQ + CTXL;
constexpr int NCH = 68;
constexpr float EPSN = 1e-6f;
constexpr int SMW = 1120;
constexpr int SM_AF = 0, SM_AB = 16, SM_CQ = 32, SM_CKV = 544, SM_KR = 1056;
constexpr int MOE_ROWS = 65536;

typedef __bf16 hwbf16x2 __attribute__((ext_vector_type(2)));
__device__ __forceinline__ unsigned cvt_pk_bf16(float lo, float hi) { const f32x2 v = {lo, hi}; return __builtin_bit_cast(unsigned, __builtin_convertvector(v, hwbf16x2)); }
__device__ __forceinline__ float bf_lo(unsigned w) { return __uint_as_float(w << 16); }
__device__ __forceinline__ float bf_hi(unsigned w) { return __uint_as_float(w & 0xffff0000u); }
__device__ __forceinline__ float bf2f(bf16_t h) { return __uint_as_float((unsigned)h << 16); }
__device__ __forceinline__ bf16_t f2bf(float f) { return (bf16_t)(cvt_pk_bf16(f, 0.f) & 0xffffu); }
__device__ __forceinline__ float wave_sum(float v) {
#pragma unroll
    for (int o = 1; o < 64; o <<= 1) v += __shfl_xor(v, o);
    return v;
}
__device__ __forceinline__ float sigmoidf_(float x) { return 1.f / (1.f + __expf(-x)); }
__device__ __forceinline__ float siluf_(float x) { return x / (1.f + __expf(-x)); }
#define LDS_WAIT() asm volatile("s_waitcnt lgkmcnt(0)" ::: "memory")
#define VM_WAIT() asm volatile("s_waitcnt vmcnt(0)" ::: "memory")

#define XB_TMO      128
#define XB_XCNT(j)  (256  + 64 * (j))
#define XB_XSUB(j)  (1280 + 64 * (j))
#define XB_XGEN(j)  (2304 + 64 * (j))
#define XB_TOP      3328
#define XB_TOPGEN   3392
#define XCD_BAR_WORDS 3456
#define XB_SPIN_CAP (1u << 18)

__device__ __forceinline__ unsigned xb_ld(unsigned* p)              { return __hip_atomic_load(p, __ATOMIC_RELAXED, __HIP_MEMORY_SCOPE_AGENT); }
__device__ __forceinline__ unsigned xb_add(unsigned* p, unsigned v) { return __hip_atomic_fetch_add(p, v, __ATOMIC_RELAXED, __HIP_MEMORY_SCOPE_AGENT); }
__device__ __forceinline__ unsigned xb_xcc_id() { return (unsigned)__builtin_amdgcn_s_getreg((3 << 11) | 20) & 0xFu; }
#define XB_SPIN(cond, bar) do { unsigned _sp = 0; while (cond) { __builtin_amdgcn_s_sleep(1); \
    if ((++_sp & 255u) == 0u) { if (xb_ld(&(bar)[XB_TMO])) break; if (_sp > XB_SPIN_CAP) { atomicAdd(&(bar)[XB_TMO], 1u); break; } } } } while (0)

struct XcdBarrier { unsigned* bar; unsigned x; volatile LAS unsigned* st; };

__device__ __forceinline__ XcdBarrier xcd_barrier_post(unsigned* bar, volatile LAS unsigned* st) {
    XcdBarrier b; b.bar = bar; b.x = xb_xcc_id(); b.st = st;
    if (threadIdx.x == 0) (void)xb_add(&bar[XB_XCNT(b.x)], 1u);
    return b;
}
__device__ __forceinline__ void xcd_barrier_complete(unsigned* bar, unsigned x, unsigned& nloc, unsigned& nx) {
    const unsigned G = gridDim.x * gridDim.y * gridDim.z;
    unsigned sum, cnt, mine, sp = 0u;
    for (;;) {
        sum = 0u; cnt = 0u; mine = 0u;
#pragma unroll
        for (unsigned j = 0; j < 16; ++j) { const unsigned c = xb_ld(&bar[XB_XCNT(j)]); sum += c; cnt += (c > 0u) ? 1u : 0u; mine = (j == x) ? c : mine; }
        if (sum == G) break;
        __builtin_amdgcn_s_sleep(1);
        if ((++sp & 255u) == 0u) { if (xb_ld(&bar[XB_TMO])) break; if (sp > XB_SPIN_CAP) { atomicAdd(&bar[XB_TMO], 1u); break; } }
    }
    nloc = mine > 0u ? mine : 1u; nx = cnt > 0u ? cnt : 1u;
}
__device__ __forceinline__ void xcd_barrier(const XcdBarrier& b) {
    asm volatile("s_waitcnt vmcnt(0)" ::: "memory");
    __syncthreads();
    if (threadIdx.x == 0) {
        unsigned* bar = b.bar;
        __builtin_amdgcn_s_waitcnt(0);
        unsigned nloc = b.st[0], nx = b.st[1];
        if (nloc == 0u) { xcd_barrier_complete(bar, b.x, nloc, nx); b.st[0] = nloc; b.st[1] = nx; }
        const unsigned old = xb_add(&bar[XB_XSUB(b.x)], 1u);
        const unsigned gen = old / nloc;
        if (old + 1u == (gen + 1u) * nloc) {
            __builtin_amdgcn_fence(__ATOMIC_RELEASE, "agent");
            asm volatile("s_waitcnt vmcnt(0)" ::: "memory");
            const unsigned og = xb_add(&bar[XB_TOP], 1u);
            const unsigned tg = og / nx;
            if (og + 1u == (tg + 1u) * nx) xb_add(&bar[XB_TOPGEN], 1u);
            else XB_SPIN(xb_ld(&bar[XB_TOPGEN]) == tg, bar);
            __builtin_amdgcn_fence(__ATOMIC_ACQUIRE, "agent");
            xb_add(&bar[XB_XGEN(b.x)], 1u);
            asm volatile("s_waitcnt vmcnt(0)" ::: "memory");
        } else {
            XB_SPIN(xb_ld(&bar[XB_XGEN(b.x)]) == gen, bar);
            __builtin_amdgcn_fence(__ATOMIC_ACQUIRE, "agent");
            asm volatile("s_waitcnt vmcnt(0)" ::: "memory");
        }
    }
    __syncthreads();
}

namespace pg8 {
constexpr int BM = 256, BK = 64, HALF = 128, HTB = HALF * BK * 2, STAGE_BYTES = 8 * HTB, NXCD = 8, WGM = 8;
__host__ __device__ __forceinline__ int lds_byte(int r, int c) { const int st = (r >> 4) * 2 + (c >> 5), rr = r & 15, cc = c & 31, ob = rr * 64 + cc * 2; return st * 1024 + (ob ^ (((ob >> 9) & 1) << 5)); }
__host__ __device__ __forceinline__ void stage_rc(int b, int& R, int& C) { const int st = b / 1024, sb = b % 1024, swz = sb ^ (((sb >> 9) & 1) << 5); R = (st >> 1) * 16 + swz / 64; C = (st & 1) * 32 + (swz % 64) / 2; }
__host__ __device__ __forceinline__ int perm32(int rho) { const int n = rho >> 4, i = rho & 15; return 8 * (i >> 2) + 4 * n + (i & 3); }

struct Unit { int pm, pn, e, half; };
struct Gemm { int lda, ldb, K; };

struct DenseOrder {
    int nM, nN, nwg, G, c; const char* A; const char* B; size_t tA, tB;
    __device__ void init(const bf16_t* A_, const bf16_t* B_, int M, int N, int lda, int ldb, int G_, int c_) { nM = M / BM; nN = N / BM; nwg = nM * nN; G = G_; c = c_; A = (const char*)A_; B = (const char*)B_; tA = (size_t)BM * lda * 2; tB = (size_t)BM * ldb * 2; }
    __device__ bool next(int i, Unit& u) const {
        const long L = (long)i * G + c; if (L >= nwg) return false;
        int wgid = (int)L; { const int q = nwg / NXCD, r = nwg % NXCD, xcd = wgid % NXCD, off = wgid / NXCD; wgid = (xcd < r ? xcd * (q + 1) : r * (q + 1) + (xcd - r) * q) + off; }
        const int nig = WGM * nN, gid = wgid / nig, fm = gid * WGM, gsz = (nM - fm) < WGM ? (nM - fm) : WGM;
        u.pm = fm + ((wgid % nig) % gsz); u.pn = (wgid % nig) / gsz; u.e = 0; u.half = 0; return true;
    }
    __device__ __forceinline__ void origin(const Unit& u, const char*& a, const char*& b) const { a = A + (size_t)u.pm * tA; b = B + (size_t)u.pn * tB; }
};
struct DualOrder {
    DenseOrder D; size_t koff; int r0, r1;
    __device__ bool next(int i, Unit& u) const { const int r = (i >> 1) + r0; if (r >= r1 || !D.next(r, u)) return false; u.e = i & 1; return true; }
    __device__ __forceinline__ void origin(const Unit& u, const char*& a, const char*& b) const { D.origin(u, a, b); a += (size_t)u.e * koff; b += (size_t)u.e * koff; }
};
struct MoeOrder {
    int tile0, ntiles, nN, G, c; const char* A; const char* B; size_t tA, tB, eB; const LAS int* tile_e; const int* rowtok;
    __device__ bool next(int i, Unit& u) const {
        int t, pn;
        if (G == 256) {
            const int x = c & 7, j = c >> 3, per = 32 / nN;
            t = i * (8 * per) + x * per + j / nN; pn = j % nN; if (t >= ntiles) return false;
        } else { const long L = (long)i * G + c; if (L >= (long)ntiles * nN) return false; t = (int)(L / nN); pn = (int)(L % nN); }
        u.pm = tile0 + t; u.pn = pn; const int te = tile_e[u.pm]; u.e = te & 63; u.half = te >> 6; return true;
    }
    __device__ __forceinline__ void origin(const Unit& u, const char*& a, const char*& b) const { a = A + (size_t)u.pm * tA; b = B + (size_t)u.e * eB + (size_t)u.pn * tB; }
};

template <class Epi, class Sched, bool ALIGN_EPI, bool GATHER = false>
__device__ __forceinline__ void gemm_phase(LAS unsigned char* lds, const Gemm g, const Sched& S, const Epi& E) {
    int tid_ = threadIdx.x; asm volatile("" : "+v"(tid_));
    const int tid = tid_, wid = __builtin_amdgcn_readfirstlane(tid >> 6), lane = tid & 63, wr = wid >> 2, wc = wid & 3, fr = lane & 15, fq = lane >> 4;
    const int K = g.K, nt = K / BK;
    unsigned voffA[2], voffB[2]; int gR[2], gC[2];
#pragma unroll
    for (int i = 0; i < 2; ++i) { int R, C; stage_rc(tid * 16 + i * 8192, R, C); const int Rb = Epi::PERM ? ((R & ~31) + perm32(R & 31)) : R;
        voffA[i] = (unsigned)(R * g.lda + C) * 2u; voffB[i] = (unsigned)(Rb * g.ldb + C) * 2u; gR[i] = R; gC[i] = C; }
    unsigned gc[2][2], gn[2][2];
#define PG8_GOFF(dst, u_) do { if constexpr (GATHER) { _Pragma("unroll") for (int h_ = 0; h_ < 2; ++h_) _Pragma("unroll") for (int i_ = 0; i_ < 2; ++i_) { \
        int tk_ = S.rowtok[(u_).pm * 256 + h_ * 128 + gR[i_]]; tk_ = tk_ < 0 ? 0 : tk_; dst[h_][i_] = (unsigned)(tk_ * g.lda + gC[i_]) * 2u; } } } while (0)
#define PG8_STAGE_A(bufoff, gbase, h_, nx_) do { if constexpr (GATHER) { _Pragma("unroll") for (int _i = 0; _i < 2; ++_i) \
        __builtin_amdgcn_global_load_lds((const unsigned*)((const char*)(gbase) + ((nx_) ? gn[h_][_i] : gc[h_][_i])), (LAS unsigned*)(lds + (bufoff) + ldsw + _i * 8192), 16, 0, 0); } \
      else { PG8_STAGE(bufoff, (gbase) + (h_) * hstepA, voffA); } } while (0)
    const size_t kstep = (size_t)(BK * 2);
    const size_t hstepA = (size_t)HALF * g.lda * 2, hstepB = (size_t)HALF * g.ldb * 2;
    const unsigned ldsw = (unsigned)wid * 1024u;
    const int aoff = lds_byte(wr * 64 + fr, fq * 8), boff = lds_byte(wc * 32 + fr, fq * 8);
#define PG8_SA(b, h) (((b) * 2 + (h)) * HTB)
#define PG8_SB(b, h) ((4 + (b) * 2 + (h)) * HTB)
#define PG8_STAGE(bufoff, gbase, voff) do { _Pragma("unroll") for (int _i = 0; _i < 2; ++_i) \
        __builtin_amdgcn_global_load_lds((const unsigned*)((const char*)(gbase) + (voff)[_i]), (LAS unsigned*)(lds + (bufoff) + ldsw + _i * 8192), 16, 0, 0); } while (0)
#define PG8_LDA(dst, b, h) do { _Pragma("unroll") for (int m = 0; m < 4; ++m) _Pragma("unroll") for (int k = 0; k < 2; ++k) dst[m][k] = *(const LAS bf16x8*)(lds + PG8_SA(b, h) + aoff + m * 2048 + k * 1024); } while (0)
#define PG8_LDB(dst, b, h) do { _Pragma("unroll") for (int n = 0; n < 2; ++n) _Pragma("unroll") for (int k = 0; k < 2; ++k) dst[n][k] = *(const LAS bf16x8*)(lds + PG8_SB(b, h) + boff + n * 2048 + k * 1024); } while (0)
#define PG8_MMA(ai, bj, At, Bt) do { __builtin_amdgcn_s_setprio(1); _Pragma("unroll") for (int m = 0; m < 4; ++m) _Pragma("unroll") for (int n = 0; n < 2; ++n) _Pragma("unroll") for (int k = 0; k < 2; ++k) \
        acc[ai][bj][m][n] = __builtin_amdgcn_mfma_f32_16x16x32_bf16(Bt[n][k], At[m][k], acc[ai][bj][m][n], 0, 0, 0); __builtin_amdgcn_s_setprio(0); } while (0)
#define PG8_WAIT_V(n) asm volatile("s_waitcnt vmcnt(" #n ")" ::: "memory")
#define PG8_WAIT_L(n) asm volatile("s_waitcnt lgkmcnt(" #n ")" ::: "memory")
#define PG8_BAR __builtin_amdgcn_s_barrier()
#define PG8_SCHED __builtin_amdgcn_sched_barrier(0)
    Unit cur, nxt; int ui = 0;
    if (!S.next(0, cur)) return;
    f32x4 acc[2][2][4][2];
#pragma unroll
    for (int a = 0; a < 2; ++a)
#pragma unroll
        for (int b = 0; b < 2; ++b)
#pragma unroll
            for (int m = 0; m < 4; ++m)
#pragma unroll
                for (int n = 0; n < 2; ++n) acc[a][b][m][n] = (f32x4){0.f, 0.f, 0.f, 0.f};
    bf16x8 At[4][2], B0[2][2], B1[2][2];
    const char* cA; const char* cB; S.origin(cur, cA, cB);
    PG8_GOFF(gc, cur);
    PG8_STAGE(PG8_SB(0, 0), cB, voffB); PG8_STAGE(PG8_SB(0, 1), cB + hstepB, voffB); PG8_STAGE_A(PG8_SA(0, 0), cA, 0, false); PG8_STAGE_A(PG8_SA(0, 1), cA, 1, false);
    if (wr == 1) PG8_BAR;
    PG8_WAIT_V(2); PG8_BAR;
    PG8_STAGE(PG8_SB(1, 0), cB + kstep, voffB); PG8_STAGE_A(PG8_SA(1, 0), cA + kstep, 0, false); PG8_STAGE(PG8_SB(1, 1), cB + hstepB + kstep, voffB);
    PG8_WAIT_V(6); PG8_BAR;
    for (;;) {
        const bool has_next = S.next(ui + 1, nxt);
        const char* nA = cA; const char* nB = cB; if (has_next) { S.origin(nxt, nA, nB); PG8_GOFF(gn, nxt); } else { if constexpr (GATHER) { _Pragma("unroll") for (int h_ = 0; h_ < 2; ++h_) _Pragma("unroll") for (int i_ = 0; i_ < 2; ++i_) gn[h_][i_] = gc[h_][i_]; } }
        for (int t = 0; t < nt; t += 2) {
            const bool last = (t == nt - 2);
            const char* a1 = cA + (size_t)(t + 1) * kstep;
            const char* a2 = last ? nA : cA + (size_t)(t + 2) * kstep; const char* b2 = last ? nB : cB + (size_t)(t + 2) * kstep;
            const char* a3 = a2 + kstep; const char* b3 = b2 + kstep;
            PG8_LDB(B0, 0, 0); PG8_LDB(B1, 0, 1); PG8_SCHED; PG8_LDA(At, 0, 0); PG8_STAGE_A(PG8_SA(1, 1), a1, 1, false);
            PG8_WAIT_V(8); PG8_WAIT_L(0); PG8_BAR; PG8_MMA(0, 0, At, B0); PG8_MMA(0, 1, At, B1); PG8_BAR; PG8_SCHED;
            PG8_LDA(At, 0, 1); PG8_STAGE(PG8_SB(0, 0), b2, voffB); PG8_STAGE(PG8_SB(0, 1), b2 + hstepB, voffB); PG8_STAGE_A(PG8_SA(0, 0), a2, 0, last);
            PG8_WAIT_V(8); PG8_WAIT_L(0); PG8_BAR; if (!cur.half) { PG8_MMA(1, 0, At, B0); PG8_MMA(1, 1, At, B1); } PG8_BAR; PG8_SCHED;
            PG8_LDB(B0, 1, 0); PG8_LDB(B1, 1, 1); PG8_SCHED; PG8_LDA(At, 1, 0); PG8_STAGE_A(PG8_SA(0, 1), a2, 1, last);
            PG8_WAIT_V(8); PG8_WAIT_L(0); PG8_BAR; PG8_MMA(0, 0, At, B0); PG8_MMA(0, 1, At, B1); PG8_BAR; PG8_SCHED;
            PG8_LDA(At, 1, 1); PG8_STAGE(PG8_SB(1, 0), b3, voffB); PG8_STAGE(PG8_SB(1, 1), b3 + hstepB, voffB); PG8_STAGE_A(PG8_SA(1, 0), a3, 0, last);
            PG8_WAIT_V(8); PG8_WAIT_L(0); PG8_BAR; if (!cur.half) { PG8_MMA(1, 0, At, B0); PG8_MMA(1, 1, At, B1); } PG8_BAR; PG8_SCHED;
        }
        if constexpr (ALIGN_EPI) { if (wr == 0) PG8_BAR; }
        E(acc, cur, wr, wc, fr, fq);
        if (!has_next) break;
        if (!(Epi::KEEP_ACC && cur.e == 0)) {
#pragma unroll
        for (int a = 0; a < 2; ++a)
#pragma unroll
            for (int b = 0; b < 2; ++b)
#pragma unroll
                for (int m = 0; m < 4; ++m)
#pragma unroll
                    for (int n = 0; n < 2; ++n) acc[a][b][m][n] = (f32x4){0.f, 0.f, 0.f, 0.f};
        }
        cur = nxt; cA = nA; cB = nB; ++ui;
        if constexpr (GATHER) { _Pragma("unroll") for (int h_ = 0; h_ < 2; ++h_) _Pragma("unroll") for (int i_ = 0; i_ < 2; ++i_) gc[h_][i_] = gn[h_][i_]; }
        if constexpr (ALIGN_EPI) { if (wr == 1) PG8_BAR; }
    }
    PG8_WAIT_V(0);
    if constexpr (!ALIGN_EPI) { if (wr == 0) PG8_BAR; }
    PG8_BAR;
#undef PG8_SA
#undef PG8_SB
#undef PG8_STAGE
#undef PG8_STAGE_A
#undef PG8_GOFF
#undef PG8_LDA
#undef PG8_LDB
#undef PG8_MMA
#undef PG8_WAIT_V
#undef PG8_WAIT_L
#undef PG8_BAR
#undef PG8_SCHED
}
}
constexpr size_t MiB = 1u << 20;
constexpr size_t WS_CTL = 0;
constexpr size_t CTL_ZERO_BYTES = 64 * 1024;
constexpr size_t WS_ROPE = 154 * MiB + 512 * 1024;
constexpr int CW_BAR = 1024;
constexpr int CW_CNT = 8192;
constexpr size_t WS_MOD  = 1 * MiB;
constexpr size_t WS_WRT  = 1 * MiB + 512 * 1024;
constexpr size_t WS_WIN  = 3 * MiB;
constexpr size_t WS_ATT  = 3 * MiB;
constexpr size_t WS_DE   = 21 * MiB;
constexpr size_t WS_ROUTE= 24 * MiB;
constexpr size_t WS_SSKR = 25 * MiB;
constexpr size_t WS_RSTD = 26 * MiB;
constexpr size_t WS_PS   = 27 * MiB;
constexpr size_t WS_WUQ  = 48 * MiB;
constexpr size_t WS_WUKV = 52 * MiB;
constexpr size_t WS_WCAT = 56 * MiB;
constexpr size_t WS_WOUT = 72 * MiB;
constexpr size_t WS_SM   = 80 * MiB;
constexpr size_t WS_QK   = 156 * MiB;
constexpr size_t WS_H    = 224 * MiB;
constexpr size_t WS_V    = 292 * MiB;
constexpr size_t WS_YCAT = 224 * MiB;
constexpr size_t WS_R    = 360 * MiB;
constexpr size_t WS_GAB  = 424 * MiB;
constexpr size_t WS_CQN  = 552 * MiB;
constexpr size_t WS_CKVN = 569 * MiB;
constexpr size_t WS_KET  = 586 * MiB;
constexpr size_t WS_Y    = 586 * MiB;
constexpr size_t WS_QRAW = 654 * MiB;
constexpr size_t WS_VM   = 750 * MiB;
constexpr size_t WS_OF   = 818 * MiB;
constexpr size_t WS_OB   = 882 * MiB;
constexpr size_t WS_KM   = 946 * MiB;
constexpr size_t WS_WGU  = 654 * MiB;
constexpr size_t WS_WD   = 910 * MiB;
constexpr size_t WS_H2S  = 156 * MiB;
constexpr size_t WS_ACT  = 416 * MiB;
constexpr size_t WS_END  = 1048 * MiB;
constexpr size_t RT_E = 0, RT_P = 128 * 1024, RT_W = 256 * 1024, RT_RSTD = 384 * 1024, RT_ROWTOK = 512 * 1024, RT_ROWW = 768 * 1024;

constexpr int LDS_BYTES = 147456;
constexpr int LDS_CTL_OFF = 145408;
constexpr int LDS_MOE_OFF = LDS_CTL_OFF + 64;

struct Params {
    const float *x, *c, *ctx, *c_ctx, *w_mod, *b_mod, *norm1_g, *norm2_g, *w_in, *w_decay_f, *b_decay_f, *w_decay_b, *b_decay_b, *gla_norm_g,
                *q_a_norm_g, *w_uq, *kv_a_norm_g, *w_ukv, *q_norm_g, *k_norm_g, *w_o_gla, *w_o_mla, *w_out, *w_rg, *b_rg, *w_re, *b_re, *w_eg, *w_eu, *w_ed;
    float* out; unsigned char* ws; int ph_lo, ph_hi;
};

using pg8::Unit;
__device__ __forceinline__ u32x4 pack8(const f32x4& a, const f32x4& b) { u32x4 w; w.x = cvt_pk_bf16(a[0], a[1]); w.y = cvt_pk_bf16(a[2], a[3]); w.z = cvt_pk_bf16(b[0], b[1]); w.w = cvt_pk_bf16(b[2], b[3]); return w; }

struct EpiProj { static constexpr bool PERM = true, KEEP_ACC = false;
    bf16_t *QK, *V, *R, *GAB; float* SM;
    __device__ __forceinline__ void operator()(f32x4 (&acc)[2][2][4][2], const Unit& u, int wr, int wc, int fr, int fq) const {
#pragma unroll
        for (int bj = 0; bj < 2; ++bj) {
            const int c = u.pn * 256 + bj * 128 + wc * 32 + 8 * fq;
            bf16_t* dst = nullptr; int ld = 0; bool lat_only = false, f32dst = false;
            if (c < 2048) { dst = QK + c; ld = 2048; }
            else if (c < 4096) { dst = V + (c - 2048); ld = 2048; }
            else if (c < 6144) { dst = R + (c - 4096); ld = 2048; lat_only = true; }
            else if (c < 7264) { f32dst = true; }
            else if (c < D_IN) { dst = GAB + (c - 7264); ld = 4096; lat_only = true; }
            else continue;
#pragma unroll
            for (int ai = 0; ai < 2; ++ai)
#pragma unroll
                for (int m = 0; m < 4; ++m) {
                    const int row = u.pm * 256 + ai * 128 + wr * 64 + m * 16 + fr;
                    if (lat_only && row >= TL) continue;
                    if (f32dst) { float* p = SM + (size_t)row * SMW + (c - 6144); *(f32x4*)p = acc[ai][bj][m][0]; *(f32x4*)(p + 4) = acc[ai][bj][m][1]; }
                    else *(u32x4*)(dst + (size_t)row * ld) = pack8(acc[ai][bj][m][0], acc[ai][bj][m][1]);
                }
        }
    }
};
struct EpiPlain { static constexpr bool PERM = true, KEEP_ACC = false;
    bf16_t* O; int ldc;
    __device__ __forceinline__ void operator()(f32x4 (&acc)[2][2][4][2], const Unit& u, int wr, int wc, int fr, int fq) const {
#pragma unroll
        for (int bj = 0; bj < 2; ++bj) { const int c = u.pn * 256 + bj * 128 + wc * 32 + 8 * fq;
#pragma unroll
            for (int ai = 0; ai < 2; ++ai)
#pragma unroll
                for (int m = 0; m < 4; ++m) { const int row = u.pm * 256 + ai * 128 + wr * 64 + m * 16 + fr;
                    *(u32x4*)(O + (size_t)row * ldc + c) = pack8(acc[ai][bj][m][0], acc[ai][bj][m][1]); } }
    }
};
struct EpiUkv { static constexpr bool PERM = true, KEEP_ACC = false;
    bf16_t *KM, *VM; const float* SSKR; float* RSTD; const float* kng; LAS float* SS;
    __device__ __forceinline__ void operator()(f32x4 (&acc)[2][2][4][2], const Unit& u, int wr, int wc, int fr, int fq) const {
        const int cw = wc * 32 + 8 * fq;
#pragma unroll
        for (int ai = 0; ai < 2; ++ai)
#pragma unroll
            for (int m = 0; m < 4; ++m) { const f32x4 a = acc[ai][0][m][0], b = acc[ai][0][m][1];
                float s = (a[0] * a[0] + a[1] * a[1]) + (a[2] * a[2] + a[3] * a[3]) + (b[0] * b[0] + b[1] * b[1]) + (b[2] * b[2] + b[3] * b[3]);
                s += __shfl_xor(s, 16); s += __shfl_xor(s, 32);
                if (fq == 0) SS[(ai * 128 + wr * 64 + m * 16 + fr) * 4 + wc] = s; }
        asm volatile("s_waitcnt lgkmcnt(0)" ::: "memory"); __builtin_amdgcn_s_barrier(); asm volatile("" ::: "memory");
        const f32x4 g0 = *(const f32x4*)(kng + cw), g1 = *(const f32x4*)(kng + cw + 4);
#pragma unroll
        for (int ai = 0; ai < 2; ++ai)
#pragma unroll
            for (int m = 0; m < 4; ++m) { const int rl = ai * 128 + wr * 64 + m * 16 + fr, row = u.pm * 256 + rl;
                int b, key; if (row < TL) { b = row >> 12; key = row & 4095; } else { const int r2 = row - TL; b = r2 >> 8; key = SEQ + (r2 & 255); }
                const f32x4 p = *(const LAS f32x4*)(SS + rl * 4);
                const float rstd = 1.f / sqrtf(((p[0] + p[1]) + (p[2] + p[3]) + SSKR[row]) * (1.f / 192.f) + EPSN);
                if (wc == 0 && fq == 0) RSTD[(size_t)row * 16 + u.pn] = rstd;
                *(u32x4*)(KM + ((size_t)(b * 16 + u.pn) * NKEY + key) * 192 + cw) = pack8(acc[ai][0][m][0] * rstd * g0, acc[ai][0][m][1] * rstd * g1);
                *(u32x4*)(VM + ((size_t)(b * 16 + u.pn) * NKEY + key) * 128 + cw) = pack8(acc[ai][1][m][0], acc[ai][1][m][1]); }
    }
};
struct EpiMerge { static constexpr bool PERM = true, KEEP_ACC = true;
    const bf16_t* GAB; bf16_t* Y;
    __device__ __forceinline__ void mid(f32x4 (&acc)[2][2][4][2], const Unit& u, int wr, int wc, int fr, int fq) const {
#pragma unroll
        for (int bj = 0; bj < 2; ++bj) { const int c = u.pn * 256 + bj * 128 + wc * 32 + 8 * fq;
#pragma unroll
            for (int ai = 0; ai < 2; ++ai)
#pragma unroll
                for (int m = 0; m < 4; ++m) { const int row = u.pm * 256 + ai * 128 + wr * 64 + m * 16 + fr;
                    const u32x4 ga = *(const u32x4*)(GAB + (size_t)row * 4096 + c), gb = *(const u32x4*)(GAB + (size_t)row * 4096 + 2048 + c);
#pragma unroll
                    for (int j = 0; j < 4; ++j) {
                        const float a0 = bf_lo(ga[j]), a1 = bf_hi(ga[j]), b0 = bf_lo(gb[j]), b1 = bf_hi(gb[j]);
                        const float r0 = (1.f + __expf(-b0)) / (1.f + __expf(-a0)), r1 = (1.f + __expf(-b1)) / (1.f + __expf(-a1));
                        acc[ai][bj][m][j >> 1][(j & 1) * 2 + 0] *= r0; acc[ai][bj][m][j >> 1][(j & 1) * 2 + 1] *= r1; }
                    asm volatile("" : "+v"(acc[ai][bj][m][0]), "+v"(acc[ai][bj][m][1]) :: "memory");
                } }
    }
    __device__ __forceinline__ void operator()(f32x4 (&acc)[2][2][4][2], const Unit& u, int wr, int wc, int fr, int fq) const {
        if (u.e == 0) { mid(acc, u, wr, wc, fr, fq); return; }
#pragma unroll
        for (int bj = 0; bj < 2; ++bj) { const int c = u.pn * 256 + bj * 128 + wc * 32 + 8 * fq;
#pragma unroll
            for (int ai = 0; ai < 2; ++ai)
#pragma unroll
                for (int m = 0; m < 4; ++m) { const int row = u.pm * 256 + ai * 128 + wr * 64 + m * 16 + fr;
                    const u32x4 gb = *(const u32x4*)(GAB + (size_t)row * 4096 + 2048 + c);
                    f32x4 v0 = acc[ai][bj][m][0], v1 = acc[ai][bj][m][1];
                    v0[0] *= sigmoidf_(bf_lo(gb[0])); v0[1] *= sigmoidf_(bf_hi(gb[0])); v0[2] *= sigmoidf_(bf_lo(gb[1])); v0[3] *= sigmoidf_(bf_hi(gb[1]));
                    v1[0] *= sigmoidf_(bf_lo(gb[2])); v1[1] *= sigmoidf_(bf_hi(gb[2])); v1[2] *= sigmoidf_(bf_lo(gb[3])); v1[3] *= sigmoidf_(bf_hi(gb[3]));
                    *(u32x4*)(Y + (size_t)row * 2048 + c) = pack8(v0, v1); } }
    }
};
struct EpiOut { static constexpr bool PERM = false, KEEP_ACC = false;
    const float* X; const float* MOD; float* O; float* PS;
    __device__ __forceinline__ void operator()(f32x4 (&acc)[2][2][4][2], const Unit& u, int wr, int wc, int fr, int fq) const {
        const int b = u.pm >> 4;
        float ssq[2][4];
#pragma unroll
        for (int ai = 0; ai < 2; ++ai)
#pragma unroll
            for (int m = 0; m < 4; ++m) ssq[ai][m] = 0.f;
#pragma unroll
        for (int bj = 0; bj < 2; ++bj) {
            const int c0 = u.pn * 256 + bj * 128 + wc * 32 + 4 * fq;
            const f32x4 gt0 = *(const f32x4*)(MOD + (size_t)b * 12288 + 4096 + c0), gt1 = *(const f32x4*)(MOD + (size_t)b * 12288 + 4096 + c0 + 16);
#pragma unroll
            for (int ai = 0; ai < 2; ++ai) {
                f32x4 xv[4][2];
#pragma unroll
                for (int m = 0; m < 4; ++m) { const int row = u.pm * 256 + ai * 128 + wr * 64 + m * 16 + fr;
                    xv[m][0] = __builtin_nontemporal_load((const f32x4*)(X + (size_t)row * 2048 + c0)); xv[m][1] = __builtin_nontemporal_load((const f32x4*)(X + (size_t)row * 2048 + c0 + 16)); }
#pragma unroll
                for (int m = 0; m < 4; ++m) { const int row = u.pm * 256 + ai * 128 + wr * 64 + m * 16 + fr;
                    const f32x4 o0 = xv[m][0] + gt0 * acc[ai][bj][m][0], o1 = xv[m][1] + gt1 * acc[ai][bj][m][1];
                    ssq[ai][m] += (o0[0] * o0[0] + o0[1] * o0[1]) + (o0[2] * o0[2] + o0[3] * o0[3]);
                    ssq[ai][m] += (o1[0] * o1[0] + o1[1] * o1[1]) + (o1[2] * o1[2] + o1[3] * o1[3]);
                    *(f32x4*)(O + (size_t)row * 2048 + c0) = o0; *(f32x4*)(O + (size_t)row * 2048 + c0 + 16) = o1; } } }
#pragma unroll
        for (int ai = 0; ai < 2; ++ai)
#pragma unroll
            for (int m = 0; m < 4; ++m) { float s = ssq[ai][m]; s += __shfl_xor(s, 16); s += __shfl_xor(s, 32);
                if (fq == 0) PS[(size_t)(u.pm * 256 + ai * 128 + wr * 64 + m * 16 + fr) * 32 + u.pn * 4 + wc] = s; }
    }
};
struct EpiGU { static constexpr bool PERM = true, KEEP_ACC = false;
    bf16_t* ACT;
    __device__ __forceinline__ void operator()(f32x4 (&acc)[2][2][4][2], const Unit& u, int wr, int wc, int fr, int fq) const {
        const int c = u.pn * 128 + wc * 32 + 8 * fq;
#pragma unroll
        for (int ai = 0; ai < 2; ++ai)
#pragma unroll
            for (int m = 0; m < 4; ++m) { const int row = u.pm * 256 + ai * 128 + wr * 64 + m * 16 + fr;
                f32x4 v0, v1;
#pragma unroll
                for (int q = 0; q < 4; ++q) { v0[q] = siluf_(acc[ai][0][m][0][q]) * acc[ai][1][m][0][q]; v1[q] = siluf_(acc[ai][0][m][1][q]) * acc[ai][1][m][1][q]; }
                *(u32x4*)(ACT + (size_t)row * 512 + c) = pack8(v0, v1); }
    }
};
struct EpiDown { static constexpr bool PERM = false, KEEP_ACC = false;
    const int* ROWTOK; const float* ROWW; const float* MOD; float* O;
    __device__ __forceinline__ void operator()(f32x4 (&acc)[2][2][4][2], const Unit& u, int wr, int wc, int fr, int fq) const {
        int tok[2][4]; float w[2][4];
#pragma unroll
        for (int ai = 0; ai < 2; ++ai)
#pragma unroll
            for (int m = 0; m < 4; ++m) { const int row = u.pm * 256 + ai * 128 + wr * 64 + m * 16 + fr; tok[ai][m] = ROWTOK[row]; w[ai][m] = ROWW[row]; }
#pragma unroll
        for (int ai = 0; ai < 2; ++ai)
#pragma unroll
            for (int m = 0; m < 4; ++m) {
                const int tk = tok[ai][m]; if (tk < 0) continue;
                const float* gp = MOD + (size_t)(tk >> 12) * 12288 + 10240 + u.pn * 256 + wc * 32 + 4 * fq;
                float* op = O + (size_t)tk * 2048 + u.pn * 256 + wc * 32 + 4 * fq;
                f32x4 gt[2][2], ov[2][2];
#pragma unroll
                for (int bj = 0; bj < 2; ++bj)
#pragma unroll
                    for (int n = 0; n < 2; ++n) { gt[bj][n] = *(const f32x4*)(gp + bj * 128 + 16 * n); ov[bj][n] = *(const f32x4*)(op + bj * 128 + 16 * n); }
#pragma unroll
                for (int bj = 0; bj < 2; ++bj)
#pragma unroll
                    for (int n = 0; n < 2; ++n) *(f32x4*)(op + bj * 128 + 16 * n) = ov[bj][n] + gt[bj][n] * (acc[ai][bj][m][n] * w[ai][m]);
            }
    }
};
struct Ctx { int tid, lane, wave, gw, ngw; LAS unsigned char* lds; };

struct TrItem { const float* W; int ldw, k0, n0; bf16_t* dst; int ldt; };
__device__ __forceinline__ void tr_load(f32x4 (&v)[8], const TrItem& t, int lane) {
    const int c4 = lane & 7, r8 = lane >> 3;
#pragma unroll
    for (int i = 0; i < 8; ++i) v[i] = __builtin_nontemporal_load((const f32x4*)(t.W + (size_t)(t.k0 + 8 * i + r8) * t.ldw + t.n0 + 4 * c4));
}
__device__ __forceinline__ void tr_store(const f32x4 (&v)[8], const TrItem& t, LAS float* scr, int lane) {
    { const int c4 = lane & 7, r8 = lane >> 3;
#pragma unroll
      for (int i = 0; i < 8; ++i) { LAS float* d = scr + (8 * i + r8) * 33 + 4 * c4; d[0] = v[i][0]; d[1] = v[i][1]; d[2] = v[i][2]; d[3] = v[i][3]; } }
    LDS_WAIT(); asm volatile("" ::: "memory");
    const int c = lane & 7;
#pragma unroll
    for (int j = 0; j < 4; ++j) { const int n = (lane >> 3) + 8 * j; const LAS float* s = scr + (8 * c) * 33 + n;
        u32x4 o; o.x = cvt_pk_bf16(s[0 * 33], s[1 * 33]); o.y = cvt_pk_bf16(s[2 * 33], s[3 * 33]); o.z = cvt_pk_bf16(s[4 * 33], s[5 * 33]); o.w = cvt_pk_bf16(s[6 * 33], s[7 * 33]);
        __builtin_nontemporal_store(o, (u32x4*)(t.dst + (size_t)n * t.ldt + 8 * c)); }
    LDS_WAIT(); asm volatile("" ::: "memory");
}
__device__ __forceinline__ TrItem conv_item(const float* W, int K, int N, bf16_t* WT, int ldt, int coloff, int it) {
    const int nblk = N / 32, kb = it / nblk, nb = it % nblk;
    return TrItem{W, N, 64 * kb, 32 * nb, WT + (size_t)(32 * nb) * ldt + coloff + 64 * kb, ldt};
}

__device__ __forceinline__ void phase0(const Params& P, const Ctx& C) {
    unsigned char* ws = P.ws;
    {
        LAS float* sc = (LAS float*)C.lds;
        LAS float* red = (LAS float*)(C.lds + 40960);
        float* MOD = (float*)(ws + WS_MOD);
        for (int i = C.tid; i < 5 * 2048; i += 512) { const int r = i >> 11, k = i & 2047; const float v = (r < 4) ? P.c[r * 2048 + k] : P.c_ctx[k]; sc[i] = v / (1.f + expf(-v)); }
        __syncthreads();
        for (int chunk = blockIdx.x; chunk < 256; chunk += gridDim.x) {
            const int n0 = chunk * 48, ks = C.tid / 12, cg = C.tid % 12;
            if (C.tid < 504) {
                f32x4 a0 = {0, 0, 0, 0}, a1 = a0, a2 = a0, a3 = a0, a4 = a0;
#pragma unroll 8
                for (int k = ks; k < 2048; k += 42) {
                    const f32x4 w = __builtin_nontemporal_load((const f32x4*)(P.w_mod + (size_t)k * 12288 + n0 + cg * 4));
                    a0 += w * sc[k]; a1 += w * sc[2048 + k]; a2 += w * sc[4096 + k]; a3 += w * sc[6144 + k]; a4 += w * sc[8192 + k];
                }
                LAS float* rp = red + ks * 240 + cg * 4;
#pragma unroll
                for (int q = 0; q < 4; ++q) { rp[q] = a0[q]; rp[48 + q] = a1[q]; rp[96 + q] = a2[q]; rp[144 + q] = a3[q]; rp[192 + q] = a4[q]; }
            }
            __syncthreads();
            if (C.tid < 240) { float s = 0.f; for (int j = 0; j < 42; ++j) s += red[j * 240 + C.tid]; const int r = C.tid / 48, n = n0 + C.tid % 48; MOD[r * 12288 + n] = s + P.b_mod[n]; }
            __syncthreads();
        }
    }
    LAS float* scr = (LAS float*)(C.lds + C.wave * 16384);
    bf16_t* WIN = (bf16_t*)(ws + WS_WIN); bf16_t* WUQ = (bf16_t*)(ws + WS_WUQ); bf16_t* WUKV = (bf16_t*)(ws + WS_WUKV); bf16_t* WCAT = (bf16_t*)(ws + WS_WCAT); bf16_t* WOUT = (bf16_t*)(ws + WS_WOUT);
    constexpr int I_IN = 32 * 355, I_UQ = 8 * 96, I_UKV = 8 * 128, I_SQ = 32 * 64;
    constexpr int NITEMS = I_IN + I_UQ + I_UKV + 3 * I_SQ;
    auto p0_item = [&](int it) -> TrItem { int r = it;
        if (r < I_IN) return conv_item(P.w_in, 2048, D_IN, WIN, 2048, 0, r); r -= I_IN;
        if (r < I_UQ) return conv_item(P.w_uq, 512, 3072, WUQ, 512, 0, r); r -= I_UQ;
        if (r < I_UKV) return conv_item(P.w_ukv, 512, 4096, WUKV, 512, 0, r); r -= I_UKV;
        if (r < I_SQ) return conv_item(P.w_o_gla, 2048, 2048, WCAT, 4096, 0, r); r -= I_SQ;
        if (r < I_SQ) return conv_item(P.w_o_mla, 2048, 2048, WCAT, 4096, 2048, r); r -= I_SQ;
        return conv_item(P.w_out, 2048, 2048, WOUT, 2048, 0, r); };
    if (C.gw < NITEMS) {
        f32x4 va[8], vb[8]; TrItem ta = p0_item(C.gw), tb = ta; tr_load(va, ta, C.lane);
        for (int it = C.gw; it < NITEMS; it += 2 * C.ngw) {
            const bool hb = it + C.ngw < NITEMS; if (hb) { tb = p0_item(it + C.ngw); tr_load(vb, tb, C.lane); }
            tr_store(va, ta, scr, C.lane);
            if (!hb) break;
            const bool ha = it + 2 * C.ngw < NITEMS; if (ha) { ta = p0_item(it + 2 * C.ngw); tr_load(va, ta, C.lane); }
            tr_store(vb, tb, scr, C.lane);
        }
    }
    {
        const int gt = blockIdx.x * 512 + C.tid, ngt = gridDim.x * 512;
        u32x4* z = (u32x4*)(WIN + (size_t)D_IN * 2048);
        for (int i = gt; i < (N_INP - D_IN) * 2048 / 8; i += ngt) z[i] = (u32x4){0u, 0u, 0u, 0u};
        float* ROPE = (float*)(ws + WS_ROPE);
        for (int i = gt; i < 4096 * 32; i += ngt) { const int t = i >> 5, part = (i >> 4) & 1, fi = i & 15;
            const float inv = exp2f(-(float)fi * (13.287712379549449f / 16.f)); float sn, cs; sincosf((float)(part ? (t & 63) : (t >> 6)) * inv, &sn, &cs);
            ROPE[(size_t)t * 64 + part * 32 + fi] = cs; ROPE[(size_t)t * 64 + part * 32 + 16 + fi] = sn; }
        bf16_t* WH = (bf16_t*)(ws + WS_WRT); bf16_t* WL = WH + 80 * 2048;
        for (int i = gt; i < 80 * 2048; i += ngt) { const int n = i >> 11, k = i & 2047;
            const float w = (n < 8) ? P.w_rg[k * 8 + n] : (n < 72 ? P.w_re[k * 64 + (n - 8)] : 0.f);
            const bf16_t h = f2bf(w); WH[i] = h; WL[i] = f2bf(w - bf2f(h)); }
    }
}

__device__ __forceinline__ void modulate_row(const float* xr, const float* g, const float* sc, const float* sh, bf16_t* o0, bf16_t* o1, float* rstd_out, int lane) {
    f32x4 v[8]; float s = 0.f;
#pragma unroll
    for (int j = 0; j < 8; ++j) { v[j] = __builtin_nontemporal_load(((const f32x4*)xr) + lane + 64 * j); s += (v[j][0] * v[j][0] + v[j][1] * v[j][1]) + (v[j][2] * v[j][2] + v[j][3] * v[j][3]); }
    const float rstd = 1.f / sqrtf(wave_sum(s) * (1.f / 2048.f) + EPSN);
    if (rstd_out && lane == 0) *rstd_out = rstd;
#pragma unroll
    for (int j = 0; j < 8; ++j) { const int i4 = lane + 64 * j; const f32x4 gg = ((const f32x4*)g)[i4], cc = ((const f32x4*)sc)[i4], hh = ((const f32x4*)sh)[i4];
        const f32x4 y = v[j] * rstd * gg * (cc + 1.f) + hh;
        u32x2 w; w.x = cvt_pk_bf16(y[0], y[1]); w.y = cvt_pk_bf16(y[2], y[3]);
        ((u32x2*)o0)[i4] = w; if (o1) ((u32x2*)o1)[i4] = w; }
}
__device__ __forceinline__ void phase1(const Params& P, const Ctx& C) {
    const float* MOD = (const float*)(P.ws + WS_MOD); bf16_t* H = (bf16_t*)(P.ws + WS_H);
    for (int r0 = C.gw; r0 < TA; r0 += 2 * C.ngw) {
        f32x4 v[2][8]; const int lane = C.lane;
#pragma unroll
        for (int u = 0; u < 2; ++u) { const int r = r0 + u * C.ngw; if (r < TA) { const float* xr = (r < TL) ? P.x + (size_t)r * 2048 : P.ctx + (size_t)(r - TL) * 2048;
#pragma unroll
            for (int j = 0; j < 8; ++j) v[u][j] = __builtin_nontemporal_load(((const f32x4*)xr) + lane + 64 * j); } }
#pragma unroll
        for (int u = 0; u < 2; ++u) { const int r = r0 + u * C.ngw; if (r < TA) { const int b = (r < TL) ? (r >> 12) : 4;
            const float* g = P.norm1_g; const float* sc = MOD + (size_t)b * 12288 + 2048; const float* sh = MOD + (size_t)b * 12288; bf16_t* o0 = H + (size_t)r * 2048;
            float s = 0.f;
#pragma unroll
            for (int j = 0; j < 8; ++j) s += (v[u][j][0] * v[u][j][0] + v[u][j][1] * v[u][j][1]) + (v[u][j][2] * v[u][j][2] + v[u][j][3] * v[u][j][3]);
            const float rstd = 1.f / sqrtf(wave_sum(s) * (1.f / 2048.f) + EPSN);
#pragma unroll
            for (int j = 0; j < 8; ++j) { const int i4 = lane + 64 * j; const f32x4 gg = ((const f32x4*)g)[i4], cc = ((const f32x4*)sc)[i4], hh = ((const f32x4*)sh)[i4];
                const f32x4 y = v[u][j] * rstd * gg * (cc + 1.f) + hh;
                u32x2 w; w.x = cvt_pk_bf16(y[0], y[1]); w.y = cvt_pk_bf16(y[2], y[3]);
                ((u32x2*)o0)[i4] = w; } } }
    }
}
__device__ __forceinline__ void phase3_tok(const Params& P, const Ctx& C) {
    const float* SM = (const float*)(P.ws + WS_SM); bf16_t* CQN = (bf16_t*)(P.ws + WS_CQN); bf16_t* CKVN = (bf16_t*)(P.ws + WS_CKVN); float* SSKR = (float*)(P.ws + WS_SSKR);
    const f32x4 gq0 = *(const f32x4*)(P.q_a_norm_g + 8 * C.lane), gq1 = *(const f32x4*)(P.q_a_norm_g + 8 * C.lane + 4);
    const f32x4 gk0 = *(const f32x4*)(P.kv_a_norm_g + 8 * C.lane), gk1 = *(const f32x4*)(P.kv_a_norm_g + 8 * C.lane + 4);
    const bool hi_only = (gridDim.x == 256);
    if (hi_only && blockIdx.x < 128) return;
    const int gw = hi_only ? C.gw - 1024 : C.gw, ngw = hi_only ? 1024 : C.ngw;
    for (int r0 = gw; r0 < TA; r0 += 4 * ngw) {
        float kv[4]; f32x4 qa[4], qb[4], ka[4], kb[4];
#pragma unroll
        for (int j = 0; j < 4; ++j) { const int r = r0 + j * ngw; if (r < TA) { const float* row = SM + (size_t)r * SMW;
            kv[j] = row[SM_KR + C.lane]; qa[j] = *(const f32x4*)(row + SM_CQ + 8 * C.lane); qb[j] = *(const f32x4*)(row + SM_CQ + 8 * C.lane + 4);
            ka[j] = *(const f32x4*)(row + SM_CKV + 8 * C.lane); kb[j] = *(const f32x4*)(row + SM_CKV + 8 * C.lane + 4); } }
#pragma unroll
        for (int j = 0; j < 4; ++j) { const int r = r0 + j * ngw; if (r < TA) {
            { const float sk = wave_sum(kv[j] * kv[j]); if (C.lane == 0) SSKR[r] = sk; }
            { const f32x4 a = qa[j], b = qb[j];
              float s = (a[0] * a[0] + a[1] * a[1]) + (a[2] * a[2] + a[3] * a[3]) + (b[0] * b[0] + b[1] * b[1]) + (b[2] * b[2] + b[3] * b[3]);
              const float rstd = 1.f / sqrtf(wave_sum(s) * (1.f / 512.f) + EPSN);
              *(u32x4*)(CQN + (size_t)r * 512 + 8 * C.lane) = pack8(a * rstd * gq0, b * rstd * gq1); }
            { const f32x4 a = ka[j], b = kb[j];
              float s = (a[0] * a[0] + a[1] * a[1]) + (a[2] * a[2] + a[3] * a[3]) + (b[0] * b[0] + b[1] * b[1]) + (b[2] * b[2] + b[3] * b[3]);
              const float rstd = 1.f / sqrtf(wave_sum(s) * (1.f / 512.f) + EPSN);
              *(u32x4*)(CKVN + (size_t)r * 512 + 8 * C.lane) = pack8(a * rstd * gk0, b * rstd * gk1); } } }
    }
}
__device__ __forceinline__ void phase5_kprep(const Params& P, const Ctx& C) {
    const float* SM = (const float*)(P.ws + WS_SM); const float* RSTD = (const float*)(P.ws + WS_RSTD); bf16_t* KM = (bf16_t*)(P.ws + WS_KM);
    const float* ROPE = (const float*)(P.ws + WS_ROPE);
    const int lane = C.lane, hs = lane >> 4, fi = lane & 15;
    const float g1r = P.k_norm_g[128 + fi], g2r = P.k_norm_g[144 + fi], g1c = P.k_norm_g[160 + fi], g2c = P.k_norm_g[176 + fi];
    for (int r0 = C.gw; r0 < TA; r0 += 4 * C.ngw) {
        float kx[4][4], rp[4][4], rs[4][4];
#pragma unroll
        for (int j = 0; j < 4; ++j) { const int r = r0 + j * C.ngw; if (r < TA) {
            const float* kr = SM + (size_t)r * SMW + SM_KR;
            kx[j][0] = kr[fi]; kx[j][1] = kr[16 + fi]; kx[j][2] = kr[32 + fi]; kx[j][3] = kr[48 + fi];
            rp[j][0] = 1.f; rp[j][1] = 0.f; rp[j][2] = 1.f; rp[j][3] = 0.f;
            if (r < TL) { const float* rt = ROPE + (size_t)(r & 4095) * 64; rp[j][0] = rt[fi]; rp[j][1] = rt[16 + fi]; rp[j][2] = rt[32 + fi]; rp[j][3] = rt[48 + fi]; }
#pragma unroll
            for (int it = 0; it < 4; ++it) rs[j][it] = RSTD[(size_t)r * 16 + it * 4 + hs]; } }
#pragma unroll
        for (int j = 0; j < 4; ++j) { const int r = r0 + j * C.ngw; if (r < TA) {
            int b, key; if (r < TL) { b = r >> 12; key = r & 4095; } else { const int r2 = r - TL; b = r2 >> 8; key = SEQ + (r2 & 255); }
            const float x1r = kx[j][0] * g1r, x2r = kx[j][1] * g2r, x1c = kx[j][2] * g1c, x2c = kx[j][3] * g2c;
            const float csr = rp[j][0], snr = rp[j][1], csc = rp[j][2], snc = rp[j][3];
            const float y1r = x1r * csr - x2r * snr, y2r = x1r * snr + x2r * csr, y1c = x1c * csc - x2c * snc, y2c = x1c * snc + x2c * csc;
#pragma unroll
            for (int it = 0; it < 4; ++it) { bf16_t* o = KM + ((size_t)(b * 16 + it * 4 + hs) * NKEY + key) * 192;
                o[128 + fi] = f2bf(y1r * rs[j][it]); o[144 + fi] = f2bf(y2r * rs[j][it]); o[160 + fi] = f2bf(y1c * rs[j][it]); o[176 + fi] = f2bf(y2c * rs[j][it]); } } }
    }
}
__device__ __forceinline__ void phase5_readout(const Params& P, const Ctx& C) {
    const bf16_t* OF = (const bf16_t*)(P.ws + WS_OF); const bf16_t* OB = (const bf16_t*)(P.ws + WS_OB); const bf16_t* R = (const bf16_t*)(P.ws + WS_R); bf16_t* YC = (bf16_t*)(P.ws + WS_YCAT);
    const f32x4 g0 = *(const f32x4*)(P.gla_norm_g + 8 * C.lane), g1 = *(const f32x4*)(P.gla_norm_g + 8 * C.lane + 4);
    u32x4 a[2], b[2], rr[2], na[2], nb[2], nr[2];
#define RO_FETCH(A_, B_, R_, it0_) do { _Pragma("unroll") for (int u = 0; u < 2; ++u) { const int it = (it0_) + u, t = it >> 2, h = it & 3; const size_t off = (size_t)t * 2048 + h * 512 + 8 * C.lane; \
        A_[u] = *(const u32x4*)(OF + off); B_[u] = *(const u32x4*)(OB + off); R_[u] = *(const u32x4*)(R + off); } } while (0)
    if (C.gw * 2 < TL * 4) RO_FETCH(na, nb, nr, C.gw * 2);
    for (int it0 = C.gw * 2; it0 < TL * 4; it0 += C.ngw * 2) {
#pragma unroll
        for (int u = 0; u < 2; ++u) { a[u] = na[u]; b[u] = nb[u]; rr[u] = nr[u]; }
        if (it0 + C.ngw * 2 < TL * 4) RO_FETCH(na, nb, nr, it0 + C.ngw * 2);
#pragma unroll
        for (int u = 0; u < 2; ++u) { const int it = it0 + u, t = it >> 2, h = it & 3;
            float o[8], rv[8]; float s = 0.f;
#pragma unroll
            for (int j = 0; j < 4; ++j) { o[2 * j] = bf_lo(a[u][j]) + bf_lo(b[u][j]); o[2 * j + 1] = bf_hi(a[u][j]) + bf_hi(b[u][j]); rv[2 * j] = bf_lo(rr[u][j]); rv[2 * j + 1] = bf_hi(rr[u][j]); }
#pragma unroll
            for (int j = 0; j < 8; ++j) s += o[j] * o[j];
            const float rstd = 1.f / sqrtf(wave_sum(s) * (1.f / 512.f) + EPSN);
            f32x4 y0, y1;
#pragma unroll
            for (int j = 0; j < 4; ++j) { y0[j] = o[j] * rstd * g0[j] * siluf_(rv[j]); y1[j] = o[4 + j] * rstd * g1[j] * siluf_(rv[4 + j]); }
#ifdef DBG_ZERO_GLA
            y0 = (f32x4){0.f, 0.f, 0.f, 0.f}; y1 = y0;
#endif
            *(u32x4*)(YC + (size_t)t * 4096 + h * 512 + 8 * C.lane) = pack8(y0, y1); }
    }
#undef RO_FETCH
}
__device__ __forceinline__ float log_sigmoidf_(float z) { return -(fmaxf(-z, 0.f) + log1pf(expf(-fabsf(z)))); }
__device__ __forceinline__ int gla_row0(int b, int c) { return (c < 4) ? (TL + b * 256 + c * 64) : (b * 4096 + (c - 4) * 64); }
constexpr int QDS_LD = 264, KET_LD = 72;

__device__ __forceinline__ float lsig16_(float z) { return (fminf(z, 0.f) - __logf(1.f + __expf(-fabsf(z)))) * 0.0625f; }
__device__ __forceinline__ void phase3_gla(const Params& P, const Ctx& C) {
    const unsigned char* ws = P.ws;
    const float* SM = (const float*)(ws + WS_SM); const bf16_t* QK = (const bf16_t*)(ws + WS_QK);
    bf16_t* QDg = (bf16_t*)(ws + WS_H); bf16_t* KETg = (bf16_t*)(ws + WS_KET); bf16_t* ATTg = (bf16_t*)(ws + WS_ATT); float* DEg = (float*)(ws + WS_DE);
    LAS float* AFs = (LAS float*)C.lds;
    LAS bf16_t* QDs = (LAS bf16_t*)(C.lds + 4096);
    LAS bf16_t* KIs = (LAS bf16_t*)(C.lds + 4096 + 64 * QDS_LD * 2);
    LAS float* Gs = (LAS float*)(C.lds + 4096 + 2 * 64 * QDS_LD * 2);
    const int tid = C.tid, half = tid >> 8, d = tid & 255;
    u32x4 nq[4], nk[4]; float naf[2]; f32x2 nw2[8]; float nbias = 0.f;
#define GLA3_FETCH(u_) do { const int dir_ = (u_) & 1, u2_ = (u_) >> 1, bh_ = u2_ / NCH, c_ = u2_ % NCH, row0_ = gla_row0(bh_ >> 2, c_), h_ = bh_ & 3, hd_ = h_ * 256 + d; \
        _Pragma("unroll") for (int k_ = 0; k_ < 4; ++k_) { const int idx_ = tid + 512 * k_, i_ = idx_ >> 5, c8_ = (idx_ & 31) * 8; \
            nq[k_] = *(const u32x4*)(QK + (size_t)(row0_ + i_) * 2048 + h_ * 256 + c8_); nk[k_] = *(const u32x4*)(QK + (size_t)(row0_ + i_) * 2048 + 1024 + h_ * 256 + c8_); } \
        _Pragma("unroll") for (int k_ = 0; k_ < 2; ++k_) { const int i_ = tid + 512 * k_; naf[k_] = SM[(size_t)(row0_ + (i_ >> 4)) * SMW + dir_ * 16 + (i_ & 15)]; } \
        const float* wd_ = dir_ ? P.w_decay_b : P.w_decay_f; \
        _Pragma("unroll") for (int j_ = 0; j_ < 8; ++j_) { nw2[j_].x = wd_[(2 * j_) * 1024 + hd_]; nw2[j_].y = wd_[(2 * j_ + 1) * 1024 + hd_]; } \
        nbias = (dir_ ? P.b_decay_b : P.b_decay_f)[hd_]; } while (0)
    if ((int)blockIdx.x < 32 * NCH) GLA3_FETCH((int)blockIdx.x);
    for (int unit = blockIdx.x; unit < 32 * NCH; unit += gridDim.x) {
        const int dir = unit & 1, u2 = unit >> 1, bh = u2 / NCH, c = u2 % NCH, b = bh >> 2, h = bh & 3, row0 = gla_row0(b, c);
        const size_t cidx = (size_t)(dir * 16 + bh) * NCH + c;
        __syncthreads();
#pragma unroll
        for (int k = 0; k < 2; ++k) AFs[tid + 512 * k] = naf[k];
#pragma unroll
        for (int k = 0; k < 4; ++k) { const int idx = tid + 512 * k, i = idx >> 5, c8 = (idx & 31) * 8;
            *(LAS u32x4*)(QDs + i * QDS_LD + c8) = nq[k]; *(LAS u32x4*)(KIs + i * QDS_LD + c8) = nk[k]; }
        f32x2 w2[8];
#pragma unroll
        for (int j = 0; j < 8; ++j) w2[j] = nw2[j];
        const float bias = nbias;
        if (unit + (int)gridDim.x < 32 * NCH) GLA3_FETCH(unit + (int)gridDim.x);
        __syncthreads();
        float rsum = 0.f;
#pragma unroll 4
        for (int ii = 0; ii < 32; ++ii) { const int i = half * 32 + ii;
            const LAS f32x4* ar = (const LAS f32x4*)(AFs + i * 16); f32x2 z2 = {bias, 0.f};
#pragma unroll
            for (int j4 = 0; j4 < 4; ++j4) { const f32x4 a = ar[j4]; z2 += (f32x2){a[0], a[1]} * w2[2 * j4]; z2 += (f32x2){a[2], a[3]} * w2[2 * j4 + 1]; }
            const float g = lsig16_(z2.x + z2.y); Gs[i * 256 + d] = g; rsum += g; }
        LAS float* hx = (LAS float*)((LAS unsigned char*)QDs + (d & 127) * (QDS_LD * 2) + 512) + (d >> 7) * 2;
        hx[half] = rsum;
        __syncthreads();
        const float other = hx[half ^ 1];
        const float bend = rsum + other, eb = __expf(bend);
        const float off = dir ? (half ? 0.f : other) : (half ? other : 0.f);
        if (half == 0) DEg[cidx * 256 + d] = eb;
        float run = 0.f;
        for (int g8 = 0; g8 < 4; ++g8) {
            float ke[8];
#pragma unroll
            for (int s = 0; s < 8; ++s) {
                const int i = half * 32 + g8 * 8 + s;
                const float g = Gs[i * 256 + d];
                float bc;
                if (dir) { bc = (rsum - run) + off; run += g; } else { run += g; bc = run + off; }
                const float qv = bf2f(QDs[i * QDS_LD + d]) * 0.0625f, kv = bf2f(KIs[i * QDS_LD + d]);
                const float ki = kv * __expf(-bc);
                ke[s] = ki * eb;
                QDs[i * QDS_LD + d] = f2bf(qv * __expf(bc)); KIs[i * QDS_LD + d] = f2bf(ki);
            }
            u32x4 w0;
            w0.x = cvt_pk_bf16(ke[0], ke[1]); w0.y = cvt_pk_bf16(ke[2], ke[3]); w0.z = cvt_pk_bf16(ke[4], ke[5]); w0.w = cvt_pk_bf16(ke[6], ke[7]);
            *(u32x4*)(KETg + cidx * 16384 + ((size_t)(((d >> 5) * 4 + half * 2 + (g8 >> 1)) * 64 + (d & 31) + 32 * (g8 & 1))) * 8) = w0;
        }
        __syncthreads();
#pragma unroll
        for (int k = 0; k < 4; ++k) { const int idx = tid + 512 * k, i = idx >> 5, c8 = (idx & 31) * 8;
            *(u32x4*)(QDg + ((size_t)dir * TA + row0 + i) * 1024 + h * 256 + c8) = *(const LAS u32x4*)(QDs + i * QDS_LD + c8); }
        {
            const int n16 = C.lane & 15, kq = C.lane >> 4, ib = C.wave & 3, jb0 = 2 * (C.wave >> 2);
            f32x4 a0 = {0, 0, 0, 0}, a1 = {0, 0, 0, 0};
            const LAS bf16_t* qa = QDs + (16 * ib + n16) * QDS_LD + 8 * kq;
            const LAS bf16_t* kb0 = KIs + (16 * jb0 + n16) * QDS_LD + 8 * kq;
            const LAS bf16_t* kb1 = kb0 + 16 * QDS_LD;
#pragma unroll
            for (int s = 0; s < 8; ++s) { const bf16x8 av = *(const LAS bf16x8*)(qa + 32 * s);
                a0 = __builtin_amdgcn_mfma_f32_16x16x32_bf16(av, *(const LAS bf16x8*)(kb0 + 32 * s), a0, 0, 0, 0);
                a1 = __builtin_amdgcn_mfma_f32_16x16x32_bf16(av, *(const LAS bf16x8*)(kb1 + 32 * s), a1, 0, 0, 0); }
#pragma unroll
            for (int r = 0; r < 4; ++r) { const int i = 16 * ib + 4 * kq + r, j0 = 16 * jb0 + n16, j1 = j0 + 16;
                const bool k0 = dir ? (j0 >= i) : (j0 <= i), k1 = dir ? (j1 >= i) : (j1 <= i);
                ATTg[(cidx * 64 + i) * 64 + j0] = f2bf(k0 ? a0[r] : 0.f); ATTg[(cidx * 64 + i) * 64 + j1] = f2bf(k1 ? a1[r] : 0.f); }
        }
    }
}

#undef GLA3_FETCH
__device__ __forceinline__ void phase4_scan(const Params& P, const Ctx& C) {
    const unsigned char* ws = P.ws;
    const bf16_t* QDg = (const bf16_t*)(ws + WS_H); const bf16_t* KETg = (const bf16_t*)(ws + WS_KET); const bf16_t* ATTg = (const bf16_t*)(ws + WS_ATT);
    const float* DEg = (const float*)(ws + WS_DE); const bf16_t* Vg = (const bf16_t*)(ws + WS_V);
    constexpr int BO_A = 0, BO_B = 53248, BO_QD = 0, BO_ATT = 33792, BO_VT = 43008, BO_DE = 52224;
    LAS bf16_t* STs = (LAS bf16_t*)(C.lds + 106496);
    const int tid = C.tid, lane = C.lane, w = C.wave;
    for (int unit = blockIdx.x; unit < 256; unit += gridDim.x) {
        const int seqid = (unit & 7) * 4 + (unit >> 6), slice = (unit >> 3) & 7, b = seqid >> 3, h = (seqid >> 1) & 3, dir = seqid & 1, bh = b * 4 + h;
        bf16_t* Og = (bf16_t*)(P.ws + (dir ? WS_OB : WS_OF));
        f32x16 S0 = {}, S1 = {};
        u32x4 rqA[4], rkA[4], raA, rvA, rqB[4], rkB[4], raB, rvB; f32x4 rdA = {0, 0, 0, 0}, rdB = {0, 0, 0, 0};
#define CHUNK_OF(step) (dir ? ((step) < 4 ? 3 - (step) : 71 - (step)) : (step))
#define GLA_LOAD(X, step) do { const int c_ = CHUNK_OF(step), row0_ = gla_row0(b, c_); const size_t cidx_ = ((size_t)(dir * 16 + bh) * NCH + c_); \
        _Pragma("unroll") for (int k_ = 0; k_ < 4; ++k_) { const int idx_ = tid + 512 * k_; \
            rq##X[k_] = *(const u32x4*)(QDg + ((size_t)dir * TA + row0_ + (idx_ >> 5)) * 1024 + h * 256 + (idx_ & 31) * 8); } \
        ra##X = *(const u32x4*)(ATTg + cidx_ * 4096 + tid * 8); \
        rv##X = *(const u32x4*)(Vg + (size_t)(row0_ + (tid >> 3)) * 2048 + h * 512 + slice * 64 + (tid & 7) * 8); \
        if (tid < 64) rd##X = *(const f32x4*)(DEg + cidx_ * 256 + tid * 4); } while (0)
#define GLA_LOADK(X, step) do { const int c_ = CHUNK_OF(step); const size_t cidx_ = ((size_t)(dir * 16 + bh) * NCH + c_); \
        _Pragma("unroll") for (int s_ = 0; s_ < 4; ++s_) rk##X[s_] = *(const u32x4*)(KETg + cidx_ * 16384 + (size_t)((w * 4 + s_) * 64 + lane) * 8); } while (0)
#define GLA_STAGE(X) do { LAS bf16_t* QDs_ = (LAS bf16_t*)(C.lds + BO_##X + BO_QD); LAS bf16_t* ATTs_ = (LAS bf16_t*)(C.lds + BO_##X + BO_ATT); LAS bf16_t* VTs_ = (LAS bf16_t*)(C.lds + BO_##X + BO_VT); \
            _Pragma("unroll") for (int k = 0; k < 4; ++k) { const int idx = tid + 512 * k; \
                *(LAS u32x4*)(QDs_ + (idx >> 5) * QDS_LD + (idx & 31) * 8) = rq##X[k]; } \
            *(LAS u32x4*)(ATTs_ + (tid >> 3) * KET_LD + (tid & 7) * 8) = ra##X; \
            { const int j = tid >> 3, e8 = (tid & 7) * 8; \
              const int js = j ^ e8;        \
              _Pragma("unroll") for (int q = 0; q < 4; ++q) { VTs_[(e8 + 2 * q) * KET_LD + js] = (bf16_t)(rv##X[q] & 0xffffu); VTs_[(e8 + 2 * q + 1) * KET_LD + js] = (bf16_t)(rv##X[q] >> 16); } } \
            if (tid < 64) *(LAS f32x4*)((LAS float*)(C.lds + BO_##X + BO_DE) + tid * 4) = rd##X; } while (0)
#define GLA_STWRITE() do {     \
                const int e = lane & 31, hh = lane >> 5; \
                _Pragma("unroll") for (int g = 0; g < 4; ++g) { u32x2 p0, p1; \
                    p0.x = cvt_pk_bf16(S0[4 * g], S0[4 * g + 1]); p0.y = cvt_pk_bf16(S0[4 * g + 2], S0[4 * g + 3]); \
                    p1.x = cvt_pk_bf16(S1[4 * g], S1[4 * g + 1]); p1.y = cvt_pk_bf16(S1[4 * g + 2], S1[4 * g + 3]); \
                    *(LAS u32x2*)(STs + e * QDS_LD + 32 * w + 8 * g + 4 * hh) = p0; \
                    *(LAS u32x2*)(STs + (32 + e) * QDS_LD + 32 * w + 8 * g + 4 * hh) = p1; } } while (0)
#define GLA_STEP(X, Y, step) do { \
            const int c = CHUNK_OF(step); \
            const LAS bf16_t* QDs = (const LAS bf16_t*)(C.lds + BO_##X + BO_QD); const LAS bf16_t* ATTs = (const LAS bf16_t*)(C.lds + BO_##X + BO_ATT); \
            const LAS bf16_t* VTs = (const LAS bf16_t*)(C.lds + BO_##X + BO_VT); const LAS float* DEs = (const LAS float*)(C.lds + BO_##X + BO_DE); \
            __syncthreads();                                     \
            if ((step) + 1 < NCH) GLA_STAGE(Y);                  \
            if ((step) + 3 < NCH) GLA_LOAD(Y, (step) + 3); \
            if (c >= 4) {     \
                const int n16 = lane & 15, kq = lane >> 4, i0 = 16 * (w & 3), e0 = 32 * (w >> 2); \
                f32x4 o0 = {0, 0, 0, 0}, o1 = {0, 0, 0, 0}; \
                _Pragma("unroll") for (int s = 0; s < 2; ++s) { const bf16x8 bi = *(const LAS bf16x8*)(ATTs + (i0 + n16) * KET_LD + 32 * s + 8 * kq); \
                    o0 = __builtin_amdgcn_mfma_f32_16x16x32_bf16(*(const LAS bf16x8*)(VTs + (e0 + n16) * KET_LD + ((32 * s + 8 * kq) ^ (((e0 + n16) >> 3) << 3))), bi, o0, 0, 0, 0); \
                    o1 = __builtin_amdgcn_mfma_f32_16x16x32_bf16(*(const LAS bf16x8*)(VTs + (e0 + 16 + n16) * KET_LD + ((32 * s + 8 * kq) ^ (((e0 + 16 + n16) >> 3) << 3))), bi, o1, 0, 0, 0); } \
                _Pragma("unroll") for (int s = 0; s < 8; ++s) { const bf16x8 bi = *(const LAS bf16x8*)(QDs + (i0 + n16) * QDS_LD + 32 * s + 8 * kq); \
                    o0 = __builtin_amdgcn_mfma_f32_16x16x32_bf16(*(const LAS bf16x8*)(STs + (e0 + n16) * QDS_LD + 32 * s + 8 * kq), bi, o0, 0, 0, 0); \
                    o1 = __builtin_amdgcn_mfma_f32_16x16x32_bf16(*(const LAS bf16x8*)(STs + (e0 + 16 + n16) * QDS_LD + 32 * s + 8 * kq), bi, o1, 0, 0, 0); } \
                  \
                bf16_t* op = Og + (size_t)(gla_row0(b, c) + i0 + n16) * 2048 + h * 512 + slice * 64 + e0 + 4 * kq; \
                u32x2 p0, p1; p0.x = cvt_pk_bf16(o0[0], o0[1]); p0.y = cvt_pk_bf16(o0[2], o0[3]); p1.x = cvt_pk_bf16(o1[0], o1[1]); p1.y = cvt_pk_bf16(o1[2], o1[3]); \
                *(u32x2*)op = p0; *(u32x2*)(op + 16) = p1; \
            } \
            {     \
                const int l31 = lane & 31, hh = lane >> 5; \
                _Pragma("unroll") for (int r = 0; r < 16; ++r) { const float de = DEs[32 * w + (r & 3) + 8 * (r >> 2) + 4 * hh]; S0[r] *= de; S1[r] *= de; } \
                _Pragma("unroll") for (int s = 0; s < 4; ++s) { const bf16x8 ak = *reinterpret_cast<const bf16x8*>(&rk##X[s]); \
                    S0 = __builtin_amdgcn_mfma_f32_32x32x16_bf16(ak, *(const LAS bf16x8*)(VTs + l31 * KET_LD + ((16 * s + 8 * hh) ^ ((l31 >> 3) << 3))), S0, 0, 0, 0); \
                    S1 = __builtin_amdgcn_mfma_f32_32x32x16_bf16(ak, *(const LAS bf16x8*)(VTs + (32 + l31) * KET_LD + ((16 * s + 8 * hh) ^ (((32 + l31) >> 3) << 3))), S1, 0, 0, 0); } \
                if ((step) + 2 < NCH) GLA_LOADK(X, (step) + 2);        \
            } \
            __syncthreads();                                     \
            GLA_STWRITE(); \
        } while (0)
        GLA_LOAD(A, 0); GLA_LOADK(A, 0); GLA_LOAD(B, 1); GLA_LOADK(B, 1);
        __syncthreads();
        GLA_STAGE(A); GLA_STWRITE(); GLA_LOAD(A, 2);
        for (int step = 0; step < NCH; step += 2) { GLA_STEP(A, B, step); GLA_STEP(B, A, step + 1); }
#undef GLA_STAGE
#undef GLA_STWRITE
#undef GLA_STEP
#undef GLA_LOAD
#undef GLA_LOADK
#undef CHUNK_OF
    }
}
namespace attn {
constexpr int NW = 8, QBLK = 32, KVBLK = 64;
constexpr float SCALE = 0.07216878364870322f;
constexpr float THR = 8.f;
constexpr int SHM_V = KVBLK * 128 * 2, SHM_K = 32 * 1056;
constexpr int OFF_V = 0, OFF_K = 3 * SHM_V, OFF_WS = OFF_K + 2 * SHM_K, SHM_ATTN = OFF_WS + NW * 64 * 4;
#define KSWZ(row, colB) (((row) >> 1) * 1056 + ((row) & 1) * 400 + (colB))
#define SBAR() __builtin_amdgcn_sched_barrier(0)
__device__ __forceinline__ int crow(int r, int hi) { return (r & 3) + 8 * (r >> 2) + 4 * hi; }

__device__ __forceinline__ void partialSM(f32x16& p0, f32x16& p1, float& m_reg, float& mn, float& alpha) {
  constexpr float Cc = SCALE * 1.4426950408889634f;
  float pmax = p0[0];
#pragma unroll
  for (int r = 1; r < 16; ++r) pmax = fmaxf(pmax, p0[r]);
#pragma unroll
  for (int r = 0; r < 16; ++r) pmax = fmaxf(pmax, p1[r]);
  { auto rr = __builtin_amdgcn_permlane32_swap(__float_as_uint(pmax), __float_as_uint(pmax), false, false);
    pmax = fmaxf(__uint_as_float(rr[0]), __uint_as_float(rr[1])); }
  if (__builtin_expect(__all(pmax - m_reg <= THR / SCALE), 1)) { mn = m_reg; alpha = 1.f; }
  else { mn = fmaxf(m_reg, pmax); alpha = __builtin_amdgcn_exp2f((m_reg - mn) * Cc); m_reg = mn; }
  const float mnC = -mn * Cc; const f32x2 c2 = {Cc, Cc}, m2 = {mnC, mnC};
#pragma unroll
  for (int r = 0; r < 8; ++r) { const f32x2 v = (f32x2){p0[2 * r], p0[2 * r + 1]} * c2 + m2;
    p0[2 * r] = __builtin_amdgcn_exp2f(v.x); p0[2 * r + 1] = __builtin_amdgcn_exp2f(v.y); }
#pragma unroll
  for (int r = 0; r < 8; ++r) { const f32x2 v = (f32x2){p1[2 * r], p1[2 * r + 1]} * c2 + m2; p1[2 * r] = v.x; p1[2 * r + 1] = v.y; }
}
__device__ __forceinline__ void finishSM(f32x16& p0, f32x16& p1, float alpha, float& l_reg, bf16x8& pa0, bf16x8& pa1, bf16x8& pa2, bf16x8& pa3) {
#pragma unroll
  for (int r = 0; r < 16; ++r) p1[r] = __builtin_amdgcn_exp2f(p1[r]);
  f32x2 ps2 = {0.f, 0.f};
#pragma unroll
  for (int r = 0; r < 8; ++r) ps2 += (f32x2){p0[2 * r], p0[2 * r + 1]};
#pragma unroll
  for (int r = 0; r < 8; ++r) ps2 += (f32x2){p1[2 * r], p1[2 * r + 1]};
  float ps = ps2.x + ps2.y;
  { auto rr = __builtin_amdgcn_permlane32_swap(__float_as_uint(ps), __float_as_uint(ps), false, false);
    ps = __uint_as_float(rr[0]) + __uint_as_float(rr[1]); }
  l_reg = l_reg * alpha + ps;
#define PK4(Pv, BASE, OUT) do { unsigned a0 = cvt_pk_bf16(Pv[BASE + 0], Pv[BASE + 1]), a1 = cvt_pk_bf16(Pv[BASE + 2], Pv[BASE + 3]);   \
    unsigned b0 = cvt_pk_bf16(Pv[BASE + 4], Pv[BASE + 5]), b1 = cvt_pk_bf16(Pv[BASE + 6], Pv[BASE + 7]);                              \
    auto r0 = __builtin_amdgcn_permlane32_swap(a0, b0, false, false); auto r1 = __builtin_amdgcn_permlane32_swap(a1, b1, false, false); \
    u32x4 w_ = {r0[0], r1[0], r0[1], r1[1]}; OUT = *reinterpret_cast<bf16x8*>(&w_); } while (0)
  PK4(p0, 0, pa0); PK4(p0, 8, pa1); PK4(p1, 0, pa2); PK4(p1, 8, pa3);
#undef PK4
}
#ifndef QK_AHEAD
#define QK_AHEAD 4
#endif
__device__ __forceinline__ void qkt(f32x16& p0, f32x16& p1, const LAS unsigned char* Ks, const bf16x8* qr, int r32, int hi) {
  p0 = f32x16{}; p1 = f32x16{};
#pragma unroll
  for (int d0 = 0; d0 < 12; ++d0) p0 = __builtin_amdgcn_mfma_f32_32x32x16_bf16(*(const LAS bf16x8*)(Ks + KSWZ(r32, (d0 * 16 + hi * 8) * 2)), qr[d0], p0, 0, 0, 0);
  __builtin_amdgcn_sched_group_barrier(0x100, QK_AHEAD, 0);
#pragma unroll
  for (int d0 = 0; d0 < 12 - QK_AHEAD; ++d0) { __builtin_amdgcn_sched_group_barrier(0x8, 1, 0); __builtin_amdgcn_sched_group_barrier(0x100, 1, 0); }
  __builtin_amdgcn_sched_group_barrier(0x8, QK_AHEAD, 0);
#pragma unroll
  for (int d0 = 0; d0 < 12; ++d0) p1 = __builtin_amdgcn_mfma_f32_32x32x16_bf16(*(const LAS bf16x8*)(Ks + KSWZ(32 + r32, (d0 * 16 + hi * 8) * 2)), qr[d0], p1, 0, 0, 0);
  __builtin_amdgcn_sched_group_barrier(0x100, QK_AHEAD, 0);
#pragma unroll
  for (int d0 = 0; d0 < 12 - QK_AHEAD; ++d0) { __builtin_amdgcn_sched_group_barrier(0x8, 1, 0); __builtin_amdgcn_sched_group_barrier(0x100, 1, 0); }
  __builtin_amdgcn_sched_group_barrier(0x8, QK_AHEAD, 0);
}
__device__ __forceinline__ int v_st(int k, int c) { const int kk = (k & ~0xC) | ((k & 4) << 1) | ((k & 8) >> 1); return ((kk >> 3) * 4 + (c >> 5)) * 512 + ((kk & 7) * 32 + (c & 31)) * 2; }
__device__ __forceinline__ int v_rd_base(int lane) { return ((lane & 3) << 3) | (((lane >> 2) & 3) << 6) | (((lane >> 4) & 1) << 5) | (((lane >> 5) & 1) << 8); }
constexpr int v_rd_off(int d0, int ks, int half) { return d0 * 512 + ks * 4096 + half * 2048; }
template <int OFF> __device__ __forceinline__ s16x4 tr_read(int vb) {
  s16x4 r; asm volatile("ds_read_b64_tr_b16 %0, %1 offset:%2" : "=&v"(r) : "v"(vb), "i"(OFF) : "memory"); return r;
}
template <int D0> __device__ __forceinline__ void pv_one(f32x16& od, int vb, bf16x8 pa0, bf16x8 pa1, bf16x8 pa2, bf16x8 pa3) {
  const s16x4 l0 = tr_read<v_rd_off(D0, 0, 0)>(vb), h0 = tr_read<v_rd_off(D0, 0, 1)>(vb), l1 = tr_read<v_rd_off(D0, 1, 0)>(vb), h1 = tr_read<v_rd_off(D0, 1, 1)>(vb);
  const s16x4 l2 = tr_read<v_rd_off(D0, 2, 0)>(vb), h2 = tr_read<v_rd_off(D0, 2, 1)>(vb), l3 = tr_read<v_rd_off(D0, 3, 0)>(vb), h3 = tr_read<v_rd_off(D0, 3, 1)>(vb);
  asm volatile("s_waitcnt lgkmcnt(0)" ::: "memory"); SBAR();
#define PKV(L, H) (bf16x8){L[0], L[1], L[2], L[3], H[0], H[1], H[2], H[3]}
  od = __builtin_amdgcn_mfma_f32_32x32x16_bf16(pa0, PKV(l0, h0), od, 0, 0, 0);
  od = __builtin_amdgcn_mfma_f32_32x32x16_bf16(pa1, PKV(l1, h1), od, 0, 0, 0);
  od = __builtin_amdgcn_mfma_f32_32x32x16_bf16(pa2, PKV(l2, h2), od, 0, 0, 0);
  od = __builtin_amdgcn_mfma_f32_32x32x16_bf16(pa3, PKV(l3, h3), od, 0, 0, 0);
#undef PKV
}
__device__ __forceinline__ void pv_d0(f32x16* o, int vb, bf16x8 pa0, bf16x8 pa1, bf16x8 pa2, bf16x8 pa3) {
  pv_one<0>(o[0], vb, pa0, pa1, pa2, pa3); pv_one<1>(o[1], vb, pa0, pa1, pa2, pa3); pv_one<2>(o[2], vb, pa0, pa1, pa2, pa3); pv_one<3>(o[3], vb, pa0, pa1, pa2, pa3);
}

template <int APROBE> __device__ __forceinline__ void attn_unit(const bf16_t* __restrict__ Qb, const bf16_t* __restrict__ Kh, const bf16_t* __restrict__ Vh, bf16_t* __restrict__ Ob,
                                          int tpos0, const float* __restrict__ qng, const float* __restrict__ rope, LAS unsigned char* lds) {
  int tid_ = threadIdx.x; asm volatile("" : "+v"(tid_));
  const int tid = tid_, wid = tid >> 6, lane = tid & 63, r32 = lane & 31, hi = lane >> 5;
  LAS unsigned char* V_lds = lds + OFF_V; LAS unsigned char* K_lds = lds + OFF_K;
  LAS float* wsf = (LAS float*)(lds + OFF_WS) + wid * 64; LAS float* li_l = wsf; LAS float* al_l = wsf + 32;
  float m_reg = -1e30f, l_reg = 0.f; f32x16 o[4]; bf16x8 qr[12];
  const int vb0 = (int)(uintptr_t)V_lds + v_rd_base(lane);
  const int wu = __builtin_amdgcn_readfirstlane(wid);
#define DMA_TILE(k0, kb, vb_) do { int l_ = lane; asm volatile("" : "+v"(l_)); \
    const char* kt_ = (const char*)Kh + (size_t)(k0) * 384 + (size_t)wu * 768; const char* vt_ = (const char*)Vh + (size_t)(k0) * 256; \
    const int rip_ = l_ >= 25 ? 1 : 0, cc_ = l_ - 25 * rip_; const unsigned ka_ = (unsigned)(rip_ * 384 + (cc_ < 24 ? cc_ : 23) * 16 - (l_ >= 50 ? 0 : 0)); \
    const unsigned kao_ = l_ >= 50 ? (unsigned)(384 + 23 * 16) : ka_; \
    _Pragma("unroll") for (int i_ = 0; i_ < 4; ++i_) \
        __builtin_amdgcn_global_load_lds((const unsigned*)(kt_ + i_ * 6144 + kao_), (LAS unsigned*)(K_lds + (kb) * SHM_K + (wu + 8 * i_) * 1056), 16, 0, 0); \
    _Pragma("unroll") for (int i_ = 0; i_ < 2; ++i_) { \
        const int kk_ = (wu << 3) | ((l_ & 31) >> 2), c_ = (((i_ << 1) | (l_ >> 5)) << 5) | ((l_ & 3) << 3), k_ = (kk_ & ~0xC) | ((kk_ & 4) << 1) | ((kk_ & 8) >> 1); \
        __builtin_amdgcn_global_load_lds((const unsigned*)(vt_ + (unsigned)(k_ * 256 + c_ * 2)), (LAS unsigned*)(V_lds + (vb_) * SHM_V + (2 * wu + i_) * 1024), 16, 0, 0); } } while (0)
#define DMA_WAIT() asm volatile("s_waitcnt vmcnt(0)" ::: "memory")
  DMA_TILE(0, 0, 0);
  {
    const bf16_t* Qw = Qb + (size_t)(wid * QBLK + r32) * 3072 + hi * 8;
    float ss = 0.f;
#pragma unroll
    for (int d0 = 0; d0 < 12; ++d0) { const u32x4 rw = *(const u32x4*)(Qw + d0 * 16);
#pragma unroll
      for (int j = 0; j < 4; ++j) { const float a = bf_lo(rw[j]), b = bf_hi(rw[j]); ss += a * a + b * b; } }
    { auto rr_ = __builtin_amdgcn_permlane32_swap(__float_as_uint(ss), __float_as_uint(ss), false, false); ss = __uint_as_float(rr_[0]) + __uint_as_float(rr_[1]); }
    const float rstd = 1.f / sqrtf(ss * (1.f / 192.f) + EPSN);
    asm volatile("" ::: "memory");
#pragma unroll
    for (int d0 = 0; d0 < 8; ++d0) { const u32x4 rw = *(const u32x4*)(Qw + d0 * 16);
      const f32x4 g0 = *(const f32x4*)(qng + d0 * 16 + hi * 8), g1 = *(const f32x4*)(qng + d0 * 16 + hi * 8 + 4);
      u32x4 w; w.x = cvt_pk_bf16(bf_lo(rw[0]) * rstd * g0[0], bf_hi(rw[0]) * rstd * g0[1]); w.y = cvt_pk_bf16(bf_lo(rw[1]) * rstd * g0[2], bf_hi(rw[1]) * rstd * g0[3]);
      w.z = cvt_pk_bf16(bf_lo(rw[2]) * rstd * g1[0], bf_hi(rw[2]) * rstd * g1[1]); w.w = cvt_pk_bf16(bf_lo(rw[3]) * rstd * g1[2], bf_hi(rw[3]) * rstd * g1[3]);
      qr[d0] = *reinterpret_cast<bf16x8*>(&w); }
    const int tpos = tpos0 + wid * QBLK + r32;
#pragma unroll
    for (int part = 0; part < 2; ++part) {
      const u32x4 ra = *(const u32x4*)(Qw + (8 + 2 * part) * 16), rb = *(const u32x4*)(Qw + (9 + 2 * part) * 16);
      const float* rt = rope + (size_t)tpos * 64 + part * 32 + 8 * hi;
      const f32x4 c0 = *(const f32x4*)rt, c1 = *(const f32x4*)(rt + 4), s0 = *(const f32x4*)(rt + 16), s1 = *(const f32x4*)(rt + 20);
      const f32x4 ga0 = *(const f32x4*)(qng + 128 + 32 * part + 8 * hi), ga1 = *(const f32x4*)(qng + 132 + 32 * part + 8 * hi), gb0 = *(const f32x4*)(qng + 144 + 32 * part + 8 * hi), gb1 = *(const f32x4*)(qng + 148 + 32 * part + 8 * hi);
      float y1[8], y2[8];
#pragma unroll
      for (int j = 0; j < 8; ++j) {
        const float x1 = ((j & 1) ? bf_hi(ra[j >> 1]) : bf_lo(ra[j >> 1])) * rstd * (j < 4 ? ga0[j & 3] : ga1[j & 3]);
        const float x2 = ((j & 1) ? bf_hi(rb[j >> 1]) : bf_lo(rb[j >> 1])) * rstd * (j < 4 ? gb0[j & 3] : gb1[j & 3]);
        const float cs = (j < 4 ? c0[j & 3] : c1[j & 3]), sn = (j < 4 ? s0[j & 3] : s1[j & 3]);
        y1[j] = x1 * cs - x2 * sn; y2[j] = x1 * sn + x2 * cs; }
      u32x4 w1, w2;
      w1.x = cvt_pk_bf16(y1[0], y1[1]); w1.y = cvt_pk_bf16(y1[2], y1[3]); w1.z = cvt_pk_bf16(y1[4], y1[5]); w1.w = cvt_pk_bf16(y1[6], y1[7]);
      w2.x = cvt_pk_bf16(y2[0], y2[1]); w2.y = cvt_pk_bf16(y2[2], y2[3]); w2.z = cvt_pk_bf16(y2[4], y2[5]); w2.w = cvt_pk_bf16(y2[6], y2[7]);
      qr[8 + 2 * part] = *reinterpret_cast<bf16x8*>(&w1); qr[9 + 2 * part] = *reinterpret_cast<bf16x8*>(&w2); }
  }
  { float z_ = 0.f; asm volatile("" : "+v"(z_));
#pragma unroll
    for (int d_ = 0; d_ < 4; ++d_)
#pragma unroll
      for (int r_ = 0; r_ < 16; ++r_) o[d_][r_] = z_; }
  constexpr int NT = NKEY / KVBLK;
#define RESC(a) do { if (__any((a) < 1.f)) { if (hi == 0) al_l[r32] = (a); asm volatile("s_waitcnt lgkmcnt(0)" ::: "memory"); \
    _Pragma("unroll") for (int d_ = 0; d_ < 4; ++d_) _Pragma("unroll") for (int r_ = 0; r_ < 16; ++r_) o[d_][r_] *= al_l[crow(r_, hi)]; } } while (0)
  f32x16 pA0, pA1, pB0, pB1; float mnA, mnB, alA, alB; bf16x8 pa0, pa1, pa2, pa3;
  DMA_WAIT(); __syncthreads();
  DMA_TILE(KVBLK, 1, 1);
  if (APROBE != 3) qkt(pA0, pA1, K_lds, qr, r32, hi); else { pA0 = f32x16{}; pA1 = f32x16{}; } if (APROBE != 1) partialSM(pA0, pA1, m_reg, mnA, alA); else { mnA = 0.f; alA = 1.f; }
  DMA_WAIT(); __syncthreads();
  int vprev = 0, vcur = 1, vnext = 2;
  for (int j = 1; j + 1 < NT; j += 2) {
    DMA_TILE((j + 1) * KVBLK, 0, vnext);
    SBAR(); if (APROBE != 3) qkt(pB0, pB1, K_lds + SHM_K, qr, r32, hi); else { pB0 = f32x16{}; pB1 = f32x16{}; }
    if (APROBE != 1) finishSM(pA0, pA1, alA, l_reg, pa0, pa1, pa2, pa3); else { pa0 = __builtin_bit_cast(bf16x8, (f32x4){pA0[0], pA0[1], pA1[0], pA1[1]}); pa1 = pa0; pa2 = pa0; pa3 = pa0; l_reg += 1.f; } SBAR();
    if (APROBE != 2) pv_d0(o, vb0 + vprev * SHM_V, pa0, pa1, pa2, pa3); if (APROBE != 1) partialSM(pB0, pB1, m_reg, mnB, alB); else { mnB = 0.f; alB = 1.f; }
    DMA_WAIT(); __syncthreads();
    RESC(alB);
    { const int t_ = vprev; vprev = vcur; vcur = vnext; vnext = t_; }
    DMA_TILE((j + 2) * KVBLK, 1, vnext);
    SBAR(); if (APROBE != 3) qkt(pA0, pA1, K_lds, qr, r32, hi); else { pA0 = f32x16{}; pA1 = f32x16{}; }
    if (APROBE != 1) finishSM(pB0, pB1, alB, l_reg, pa0, pa1, pa2, pa3); else { pa0 = __builtin_bit_cast(bf16x8, (f32x4){pB0[0], pB0[1], pB1[0], pB1[1]}); pa1 = pa0; pa2 = pa0; pa3 = pa0; l_reg += 1.f; } SBAR();
    if (APROBE != 2) pv_d0(o, vb0 + vprev * SHM_V, pa0, pa1, pa2, pa3); if (APROBE != 1) partialSM(pA0, pA1, m_reg, mnA, alA); else { mnA = 0.f; alA = 1.f; }
    DMA_WAIT(); __syncthreads();
    RESC(alA);
    { const int t_ = vprev; vprev = vcur; vcur = vnext; vnext = t_; }
  }
  SBAR(); if (APROBE != 3) qkt(pB0, pB1, K_lds + SHM_K, qr, r32, hi); else { pB0 = f32x16{}; pB1 = f32x16{}; }
  if (APROBE != 1) finishSM(pA0, pA1, alA, l_reg, pa0, pa1, pa2, pa3); else { pa0 = __builtin_bit_cast(bf16x8, (f32x4){pA0[0], pA0[1], pA1[0], pA1[1]}); pa1 = pa0; pa2 = pa0; pa3 = pa0; l_reg += 1.f; } SBAR();
  if (APROBE != 2) pv_d0(o, vb0 + vprev * SHM_V, pa0, pa1, pa2, pa3); if (APROBE != 1) partialSM(pB0, pB1, m_reg, mnB, alB); else { mnB = 0.f; alB = 1.f; }
  RESC(alB);
  if (APROBE != 1) finishSM(pB0, pB1, alB, l_reg, pa0, pa1, pa2, pa3); else { pa0 = __builtin_bit_cast(bf16x8, (f32x4){pB0[0], pB0[1], pB1[0], pB1[1]}); pa1 = pa0; pa2 = pa0; pa3 = pa0; l_reg += 1.f; } SBAR();
  if (APROBE != 2) pv_d0(o, vb0 + vcur * SHM_V, pa0, pa1, pa2, pa3);
#undef RESC
  if (hi == 0) li_l[r32] = l_reg; asm volatile("s_waitcnt lgkmcnt(0)" ::: "memory");
  bf16_t* Ow = Ob + (size_t)(wid * QBLK + 4 * hi) * 4096 + r32;
  asm volatile("" : "+v"(Ow));
#pragma unroll
  for (int r = 0; r < 16; ++r) { const int orow = crow(r, hi); const float rl = __builtin_amdgcn_rcpf(li_l[orow]);
#pragma unroll
    for (int d0 = 0; d0 < 4; ++d0) {
#ifdef DBG_ZERO_MLA
      Ow[(size_t)((r & 3) + 8 * (r >> 2)) * 4096 + d0 * 32] = 0;
#else
      if (APROBE == 0) Ow[(size_t)((r & 3) + 8 * (r >> 2)) * 4096 + d0 * 32] = f2bf(o[d0][r] * rl);
      else if (o[d0][r] * rl == 12345.678f) Ow[0] = 0;
#endif
    } }
  __syncthreads();
#undef DMA_TILE
#undef DMA_WAIT
}
#undef KSWZ
#undef SBAR
}

template <int APROBE> __device__ __forceinline__ void phase6_attn(const Params& P, const Ctx& C) {
    const bf16_t* QRAW = (const bf16_t*)(P.ws + WS_QRAW); const bf16_t* KM = (const bf16_t*)(P.ws + WS_KM); const bf16_t* VM = (const bf16_t*)(P.ws + WS_VM); bf16_t* YC = (bf16_t*)(P.ws + WS_YCAT);
    const int G = gridDim.x, c = blockIdx.x;
    for (int i = 0;; ++i) {
        int bh, qb;
        if (G == 256) { if (i >= 4) break; const int x = c & 7, jx = c >> 3; bh = x * 8 + i * 2 + (jx >> 4); qb = jx & 15; }
        else { const int U = i * G + c; if (U >= 1024) break; bh = U >> 4; qb = U & 15; }
        const int b = bh >> 4, h = bh & 15;
        attn::attn_unit<APROBE>(QRAW + (size_t)(b * 4096 + qb * 256) * 3072 + h * 192, KM + (size_t)bh * NKEY * 192, VM + (size_t)bh * NKEY * 128,
                        YC + (size_t)(b * 4096 + qb * 256) * 4096 + 2048 + h * 128, qb * 256, P.q_norm_g, (const float*)(P.ws + WS_ROPE), C.lds);
    }
}
constexpr int CONV_P10 = 224 * 16;
constexpr int CONV_P9 = 16384;
__device__ __forceinline__ void expert_conv(const Params& P, const Ctx& C, const int it_lo, const int it_hi) {
    unsigned char* ws = P.ws;
    __syncthreads();
    LAS float* scr = (LAS float*)(C.lds + C.wave * 16384);
    bf16_t* WGU = (bf16_t*)(ws + WS_WGU); bf16_t* WD = (bf16_t*)(ws + WS_WD);
    auto ex_item = [&](int it) -> TrItem { const int e = it / 1536, r = it % 1536;
        if (r < 1024) { const int up = r >> 9, q = r & 511, kb = q >> 4, nb = q & 15, n0 = 32 * nb;
            const float* W = (up ? P.w_eu : P.w_eg) + (size_t)e * 2048 * 512;
            const int drow = (n0 >> 7) * 256 + up * 128 + (n0 & 127);
            return TrItem{W, 512, 64 * kb, n0, WGU + ((size_t)e * 1024 + drow) * 2048 + 64 * kb, 2048}; }
        const int q = r - 1024, kb = q >> 6, nb = q & 63;
        return TrItem{P.w_ed + (size_t)e * 512 * 2048, 2048, 64 * kb, 32 * nb, WD + ((size_t)e * 2048 + 32 * nb) * 512 + 64 * kb, 512}; };
    const int it0 = it_lo + C.wave, it_st = 8;
    if (it0 < it_hi) {
        f32x4 va[8], vb[8]; TrItem ta = ex_item(it0), tb = ta; tr_load(va, ta, C.lane);
        for (int it = it0; it < it_hi; it += 2 * it_st) {
            const bool hb = it + it_st < it_hi; if (hb) { tb = ex_item(it + it_st); tr_load(vb, tb, C.lane); }
            tr_store(va, ta, scr, C.lane);
            if (!hb) break;
            const bool ha = it + 2 * it_st < it_hi; if (ha) { ta = ex_item(it + 2 * it_st); tr_load(va, ta, C.lane); }
            tr_store(vb, tb, scr, C.lane);
        }
    }
    __syncthreads();
}
constexpr int RB_LD = 136;
__device__ __forceinline__ void phase9_router(const Params& P, const Ctx& C, const int mode9, const bool dry) {
    unsigned char* ws = P.ws;
    if (mode9 & 2) {
        const float* XM = P.out; const float* MOD = (const float*)(ws + WS_MOD);
        const bf16_t* WH = (const bf16_t*)(ws + WS_WRT);
        int* RTE = (int*)(ws + WS_ROUTE + RT_E); int* RTP = (int*)(ws + WS_ROUTE + RT_P); float* RTW = (float*)(ws + WS_ROUTE + RT_W);
        unsigned* CNT = (unsigned*)(ws + WS_CTL) + CW_CNT; bf16_t* H2 = (bf16_t*)(ws + WS_H2S);
        LAS bf16_t* Bs = (LAS bf16_t*)C.lds;
        LAS float* LG = (LAS float*)(C.lds + 87040) + C.wave * 1280;
        const int r = C.lane & 15, kq = C.lane >> 4;
        const bool xsplit = (gridDim.x == 256);
        for (int pass = xsplit ? (((int)blockIdx.x & 7) < 4 ? ((int)blockIdx.x >> 3) * 4 + ((int)blockIdx.x & 7) : TL) : (int)blockIdx.x; pass < TL / 128; pass += xsplit ? TL : (int)gridDim.x) {
            const int t = pass * 128 + C.wave * 16 + r, b = (pass * 128) >> 12;
            const float* xr = XM + (size_t)t * 2048 + 8 * kq;
            float ss;
            { const float* ps = (const float*)(ws + WS_PS) + (size_t)t * 32 + 8 * kq; const f32x4 a = *(const f32x4*)ps, c2 = *(const f32x4*)(ps + 4);
              ss = ((a[0] + a[1]) + (a[2] + a[3])) + ((c2[0] + c2[1]) + (c2[2] + c2[3])); }
            ss += __shfl_xor(ss, 16); ss += __shfl_xor(ss, 32);
            const float rstd = 1.f / sqrtf(ss * (1.f / 2048.f) + EPSN);
            LAS float* A2s = (LAS float*)(C.lds + 128000); LAS float* B2s = A2s + 2048;
            { const float* sc2 = MOD + (size_t)b * 12288 + 8192; const float* sh2 = MOD + (size_t)b * 12288 + 6144;
              const f32x4 gv = ((const f32x4*)P.norm2_g)[C.tid], cv = ((const f32x4*)sc2)[C.tid], sv = ((const f32x4*)sh2)[C.tid];
              ((LAS f32x4*)A2s)[C.tid] = gv * (cv + 1.f); ((LAS f32x4*)B2s)[C.tid] = sv; }
            f32x4 acc[5];
#pragma unroll
            for (int n = 0; n < 5; ++n) acc[n] = (f32x4){0.f, 0.f, 0.f, 0.f};
            u32x4 wreg[5]; f32x4 xA[4], xB[4];
#define RB_LOAD(ch) do { _Pragma("unroll") for (int i_ = 0; i_ < 5; ++i_) { const int p_ = C.tid + 512 * i_, wh_ = p_ / 1280, rem_ = p_ % 1280; \
                wreg[i_] = *(const u32x4*)(WH + (size_t)wh_ * (80 * 2048) + (size_t)(rem_ >> 4) * 2048 + 128 * (ch) + (rem_ & 15) * 8); } } while (0)
#define RX_LOAD(X, ch, part) do { _Pragma("unroll") for (int i_ = 0; i_ < 4; ++i_) X[i_] = *(const f32x4*)(xr + 128 * (ch) + 64 * (part) + 32 * (i_ >> 1) + 4 * (i_ & 1)); } while (0)
#define RB_STEP(X, xi, ch, s4) do { \
                    const int ko = 128 * (ch) + 32 * (s4) + 8 * kq; \
                    float hv[8]; \
                    _Pragma("unroll") for (int q = 0; q < 2; ++q) { const f32x4 av = *(const LAS f32x4*)(A2s + ko + 4 * q), bv = *(const LAS f32x4*)(B2s + ko + 4 * q); \
                        const f32x4 y = X[2 * (xi) + q] * rstd * av + bv; hv[4 * q] = y[0]; hv[4 * q + 1] = y[1]; hv[4 * q + 2] = y[2]; hv[4 * q + 3] = y[3]; } \
                    u32x4 wh, wl; \
                    _Pragma("unroll") for (int q = 0; q < 4; ++q) { const unsigned ph = cvt_pk_bf16(hv[2 * q], hv[2 * q + 1]); wh[q] = ph; wl[q] = cvt_pk_bf16(hv[2 * q] - bf_lo(ph), hv[2 * q + 1] - bf_hi(ph)); } \
                    if (!dry) *(u32x4*)(H2 + (size_t)t * 2048 + ko) = wh;        \
                    const bf16x8 ahi = *reinterpret_cast<bf16x8*>(&wh), alo = *reinterpret_cast<bf16x8*>(&wl); \
                    _Pragma("unroll") for (int n = 0; n < 5; ++n) { const LAS bf16_t* bp = Bb + (16 * n + r) * RB_LD + 32 * (s4) + 8 * kq; \
                        const bf16x8 bh = *(const LAS bf16x8*)bp, bl = *(const LAS bf16x8*)(bp + 80 * RB_LD); \
                        acc[n] = __builtin_amdgcn_mfma_f32_16x16x32_bf16(bh, ahi, acc[n], 0, 0, 0); \
                        acc[n] = __builtin_amdgcn_mfma_f32_16x16x32_bf16(bl, ahi, acc[n], 0, 0, 0); \
                        acc[n] = __builtin_amdgcn_mfma_f32_16x16x32_bf16(bh, alo, acc[n], 0, 0, 0); } \
                } while (0)
            RB_LOAD(0); RX_LOAD(xA, 0, 0); RX_LOAD(xB, 0, 1);
            for (int ch = 0; ch < 16; ++ch) {
                LAS bf16_t* Bb = Bs + (ch & 1) * (2 * 80 * RB_LD);
#pragma unroll
                for (int i = 0; i < 5; ++i) { const int p_ = C.tid + 512 * i, wh_ = p_ / 1280, rem_ = p_ % 1280;
                    *(LAS u32x4*)(Bb + (wh_ * 80 + (rem_ >> 4)) * RB_LD + (rem_ & 15) * 8) = wreg[i]; }
                __syncthreads();
                if (ch + 1 < 16) RB_LOAD(ch + 1);
                RB_STEP(xA, 0, ch, 0); __builtin_amdgcn_sched_barrier(0); RB_STEP(xA, 1, ch, 1); __builtin_amdgcn_sched_barrier(0);
                if (ch + 1 < 16) RX_LOAD(xA, ch + 1, 0);
                RB_STEP(xB, 0, ch, 2); __builtin_amdgcn_sched_barrier(0); RB_STEP(xB, 1, ch, 3); __builtin_amdgcn_sched_barrier(0);
                if (ch + 1 < 16) RX_LOAD(xB, ch + 1, 1);
            }
#undef RB_LOAD
#undef RX_LOAD
#undef RB_STEP
#pragma unroll
            for (int n = 0; n < 5; ++n) *(LAS f32x4*)(LG + r * 80 + 16 * n + 4 * kq) = acc[n];
            LDS_WAIT(); asm volatile("" ::: "memory");
            if (C.lane < 16 && !dry) {
                const LAS float* lg = LG + C.lane * 80;
                float gm = -3.0e38f; int gi = 0; float gl[8];
#pragma unroll
                for (int j = 0; j < 8; ++j) { gl[j] = lg[j] + P.b_rg[j]; if (gl[j] > gm) { gm = gl[j]; gi = j; } }
                float gs = 0.f;
#pragma unroll
                for (int j = 0; j < 8; ++j) gs += expf(gl[j] - gm);
                const float pg = 1.f / gs;
                float b1 = -3.0e38f, b2 = -3.0e38f; int i1 = 0, i2 = 0;
#pragma unroll
                for (int j = 0; j < 8; ++j) { const float v = lg[8 + gi * 8 + j] + P.b_re[gi * 8 + j];
                    if (v > b1) { b2 = b1; i2 = i1; b1 = v; i1 = j; } else if (v > b2) { b2 = v; i2 = j; } }
                const float e2 = expf(b2 - b1), w1 = pg / (1.f + e2), w2 = pg * e2 / (1.f + e2);
                const int ea = gi * 8 + i1, eb = gi * 8 + i2;
                const int pa = (int)__hip_atomic_fetch_add(CNT + ea, 1u, __ATOMIC_RELAXED, __HIP_MEMORY_SCOPE_AGENT);
                const int pb = (int)__hip_atomic_fetch_add(CNT + 64 + eb, 1u, __ATOMIC_RELAXED, __HIP_MEMORY_SCOPE_AGENT);
                RTE[2 * t] = ea; RTE[2 * t + 1] = eb; RTP[2 * t] = pa; RTP[2 * t + 1] = pb; RTW[2 * t] = w1; RTW[2 * t + 1] = w2;
            }
            __syncthreads();
        }
    }
    if (mode9 & 1) {
        { int* ROWTOK = (int*)(ws + WS_ROUTE + RT_ROWTOK); for (int i = blockIdx.x * 512 + C.tid; i < MOE_ROWS; i += gridDim.x * 512) ROWTOK[i] = -1; }
        __syncthreads();
        if (gridDim.x == 256 && (blockIdx.x & 7) >= 4) { const int clo = (((int)blockIdx.x >> 3) * 4 + ((int)blockIdx.x & 7) - 4) * (CONV_P9 / 128); expert_conv(P, C, clo, clo + CONV_P9 / 128); }
    }
}
template <bool WANT_BASE> __device__ __forceinline__ void moe_tables(const Params& P, const Ctx& C, LAS int* base, LAS int* tab) {
    const unsigned* CNT = (const unsigned*)(P.ws + WS_CTL) + CW_CNT;
    LAS int* cs = WANT_BASE ? base + 128 : tab + 300;
    if (C.tid < 128) cs[C.tid] = (int)CNT[C.tid];
    __syncthreads();
    if (C.tid < 128) { int start = 0;
#pragma unroll
        for (int g4 = 0; g4 < 32; ++g4) { const u32x4 v = *(const LAS u32x4*)(cs + 4 * g4);
#pragma unroll
            for (int q = 0; q < 4; ++q) start += (4 * g4 + q < C.tid) ? (int)((v[q] + 255u) >> 8) : 0; }
        const int cnt_ = cs[C.tid], nt = (cnt_ + 255) >> 8;
        if constexpr (WANT_BASE) base[C.tid] = start * 256;
        else { for (int j = 0; j < nt; ++j) tab[4 + start + j] = (C.tid & 63) | ((cnt_ - 256 * j <= 128) ? 64 : 0);
               if (C.tid == 63) tab[1] = start + nt; if (C.tid == 127) tab[0] = start + nt; } }
    __syncthreads();
}
__device__ __forceinline__ void phase10_dispatch(const Params& P, const Ctx& C) {
    unsigned char* ws = P.ws;
    LAS int* base = (LAS int*)C.lds;
    moe_tables<true>(P, C, base, base);
    const int* RTE = (const int*)(ws + WS_ROUTE + RT_E); const int* RTP = (const int*)(ws + WS_ROUTE + RT_P); const float* RTW = (const float*)(ws + WS_ROUTE + RT_W);
    int* ROWTOK = (int*)(ws + WS_ROUTE + RT_ROWTOK); float* ROWW = (float*)(ws + WS_ROUTE + RT_ROWW);
    for (int t = blockIdx.x * 512 + C.tid; t < TL; t += gridDim.x * 512) {
        const int r0 = base[RTE[2 * t] & 63] + RTP[2 * t], r1 = base[64 + (RTE[2 * t + 1] & 63)] + RTP[2 * t + 1];
        ROWTOK[r0] = t; ROWW[r0] = RTW[2 * t]; ROWTOK[r1] = t; ROWW[r1] = RTW[2 * t + 1];
    }
    if (gridDim.x == 256 && blockIdx.x >= 32) { const int clo = CONV_P9 + ((int)blockIdx.x - 32) * 16; expert_conv(P, C, clo, clo + 16); }
}

constexpr int N_PHASES = 14;
__global__ void __launch_bounds__(512, 2) mega_fwd(Params PK) {
    extern __shared__ __attribute__((aligned(16))) unsigned char lds_raw[];
#if defined(__HIP_DEVICE_COMPILE__)
#define KARGS(p_) (*(p_))
#else
#define KARGS(p_) (PK)
#endif
#define MKCTX() const __attribute__((address_space(4))) Params* pk_ = (const __attribute__((address_space(4))) Params*)__builtin_amdgcn_kernarg_segment_ptr(); \
    asm volatile("" : "+s"(pk_)); const Params P = KARGS(pk_); unsigned char* const ws = P.ws; Ctx C; { int t_ = threadIdx.x; asm volatile("" : "+v"(t_)); C.lds = (LAS unsigned char*)lds_raw; C.tid = t_; C.lane = t_ & 63; C.wave = __builtin_amdgcn_readfirstlane(t_ >> 6); C.gw = blockIdx.x * 8 + C.wave; C.ngw = gridDim.x * 8; }
    LAS unsigned char* const lds0 = (LAS unsigned char*)lds_raw;
    unsigned char* const ws0 = PK.ws;
    for (int u = threadIdx.x; u < (LDS_BYTES - LDS_CTL_OFF) / 4; u += 512) ((LAS unsigned*)(lds0 + LDS_CTL_OFF))[u] = 0u;
    __syncthreads();
    const int lo = PK.ph_lo, hi = PK.ph_hi;
    XcdBarrier bar; bar.bar = (unsigned*)(ws0 + WS_CTL) + CW_BAR; bar.x = 0; bar.st = nullptr;
    if (hi - lo > 1) bar = xcd_barrier_post((unsigned*)(ws0 + WS_CTL) + CW_BAR, (volatile LAS unsigned*)(lds0 + LDS_CTL_OFF));
#ifndef PH_MASK
#define PH_MASK 0x3fff
#endif
#define IN(k) (((PH_MASK >> (k)) & 1) && lo <= (k) && (k) < hi)
#define SEAM(k) do { if (IN(k) && IN((k) + 1)) xcd_barrier(bar); } while (0)
#ifndef REP_MASK
#define REP_MASK 0
#endif
#define REPEAT(k) for (int rep_ = 0; rep_ < 1 + ((REP_MASK >> (k)) & 1); ++rep_)
#define REPSYNC() do { if (rep_) xcd_barrier(bar); } while (0)
    const int G = gridDim.x, cb = blockIdx.x;

    if (IN(0)) REPEAT(0) { REPSYNC(); MKCTX(); phase0(P, C); } SEAM(0);
    if (IN(1)) REPEAT(1) { REPSYNC(); MKCTX(); phase1(P, C); } SEAM(1);
    if (IN(2)) REPEAT(2) { REPSYNC(); MKCTX();
        pg8::DenseOrder S; S.init((const bf16_t*)(ws + WS_H), (const bf16_t*)(ws + WS_WIN), TA, N_INP, 2048, 2048, G, cb);
        EpiProj E{(bf16_t*)(ws + WS_QK), (bf16_t*)(ws + WS_V), (bf16_t*)(ws + WS_R), (bf16_t*)(ws + WS_GAB), (float*)(ws + WS_SM)};
        pg8::gemm_phase<EpiProj, pg8::DenseOrder, true>(C.lds, pg8::Gemm{2048, 2048, 2048}, S, E);
    } SEAM(2);
    if (IN(3)) REPEAT(3) { REPSYNC(); MKCTX(); phase3_tok(P, C); phase3_gla(P, C); } SEAM(3);
    if (IN(4)) REPEAT(4) { REPSYNC(); MKCTX();
#ifndef DBG_NO_UQKV
        {
            pg8::DenseOrder S; S.init((const bf16_t*)(ws + WS_CQN), (const bf16_t*)(ws + WS_WUQ), TL, 3072, 512, 512, G, cb);
            EpiPlain E{(bf16_t*)(ws + WS_QRAW), 3072};
            pg8::gemm_phase<EpiPlain, pg8::DenseOrder, true>(C.lds, pg8::Gemm{512, 512, 512}, S, E);
        }
        {
            pg8::DenseOrder S; S.init((const bf16_t*)(ws + WS_CKVN), (const bf16_t*)(ws + WS_WUKV), TA, 4096, 512, 512, G, cb);
            EpiUkv E{(bf16_t*)(ws + WS_KM), (bf16_t*)(ws + WS_VM), (const float*)(ws + WS_SSKR), (float*)(ws + WS_RSTD), P.k_norm_g, (LAS float*)(C.lds + 131072)};
            pg8::gemm_phase<EpiUkv, pg8::DenseOrder, true>(C.lds, pg8::Gemm{512, 512, 512}, S, E);
        }
#endif
        phase4_scan(P, C);
#if (REP_MASK >> 15) & 1
        phase4_scan(P, C);
#endif
    } SEAM(4);
    if (IN(5)) REPEAT(5) { REPSYNC(); MKCTX(); phase5_kprep(P, C); phase5_readout(P, C); } SEAM(5);
#ifndef APROBE_MODE
#define APROBE_MODE 0
#endif
    if (IN(6)) { { MKCTX(); phase6_attn<0>(P, C); }
#if (REP_MASK >> 6) & 1
        { xcd_barrier(bar); MKCTX(); phase6_attn<APROBE_MODE>(P, C); }
#endif
    } SEAM(6);
    if (IN(7)) REPEAT(7) { REPSYNC(); MKCTX();
        pg8::DualOrder S; S.D.init((const bf16_t*)(ws + WS_YCAT), (const bf16_t*)(ws + WS_WCAT), TL, 2048, 4096, 4096, G, cb); S.koff = (size_t)2048 * 2;
        EpiMerge E{(const bf16_t*)(ws + WS_GAB), (bf16_t*)(ws + WS_Y)};
#pragma nounroll
        for (int stage = 0; stage < 3; ++stage) {
            if ((((int)blockIdx.x & 7) % 3) == stage) {
                const int g_ = (int)gridDim.x, base = (g_ == 256) ? CONV_P9 + CONV_P10 : 0, cper = (64 * 1536 - base + g_ - 1) / g_, clo = base + (int)blockIdx.x * cper;
                expert_conv(P, C, clo, (clo + cper < 64 * 1536) ? clo + cper : 64 * 1536); }
            if (stage == 2) break;
            S.r0 = stage; S.r1 = stage ? (1 << 30) : 1;
            pg8::gemm_phase<EpiMerge, pg8::DualOrder, true>(C.lds, pg8::Gemm{4096, 4096, 2048}, S, E);
        }
    } SEAM(7);
    if (IN(8)) REPEAT(8) { REPSYNC(); MKCTX();
        pg8::DenseOrder S; S.init((const bf16_t*)(ws + WS_Y), (const bf16_t*)(ws + WS_WOUT), TL, 2048, 2048, 2048, G, cb);
        EpiOut E{P.x, (const float*)(ws + WS_MOD), P.out, (float*)(ws + WS_PS)};
        pg8::gemm_phase<EpiOut, pg8::DenseOrder, true>(C.lds, pg8::Gemm{2048, 2048, 2048}, S, E);
    } SEAM(8);
    if (IN(9)) { { MKCTX(); phase9_router(P, C, 3, false); }
#if (REP_MASK >> 13) & 1
        { xcd_barrier(bar); MKCTX(); phase9_router(P, C, 1, false); }
#endif
#if (REP_MASK >> 14) & 1
        { xcd_barrier(bar); MKCTX(); phase9_router(P, C, 2, true); }
#endif
    } SEAM(9);
    if (IN(10)) REPEAT(10) { REPSYNC(); MKCTX(); phase10_dispatch(P, C); } SEAM(10);
    if (IN(11)) REPEAT(11) { REPSYNC(); MKCTX();
        LAS int* tab = (LAS int*)(C.lds + LDS_MOE_OFF);
        moe_tables<false>(P, C, tab, tab);
        pg8::MoeOrder S; S.tile0 = 0; S.ntiles = tab[0]; S.nN = 4; S.G = G; S.c = cb; S.A = (const char*)(ws + WS_H2S); S.B = (const char*)(ws + WS_WGU);
        S.tA = 0; S.tB = (size_t)256 * 2048 * 2; S.eB = (size_t)1024 * 2048 * 2; S.tile_e = tab + 4; S.rowtok = (const int*)(ws + WS_ROUTE + RT_ROWTOK);
        EpiGU E{(bf16_t*)(ws + WS_ACT)};
        pg8::gemm_phase<EpiGU, pg8::MoeOrder, true, true>(C.lds, pg8::Gemm{2048, 2048, 2048}, S, E);
    } SEAM(11);
    if (IN(12)) { MKCTX();
        LAS int* tab = (LAS int*)(C.lds + LDS_MOE_OFF);
        moe_tables<false>(P, C, tab, tab);
        pg8::MoeOrder S; S.tile0 = 0; S.ntiles = tab[1]; S.nN = 8; S.G = G; S.c = cb; S.A = (const char*)(ws + WS_ACT); S.B = (const char*)(ws + WS_WD);
        S.tA = (size_t)256 * 512 * 2; S.tB = (size_t)256 * 512 * 2; S.eB = (size_t)2048 * 512 * 2; S.tile_e = tab + 4; S.rowtok = nullptr;
        EpiDown E{(const int*)(ws + WS_ROUTE + RT_ROWTOK), (const float*)(ws + WS_ROUTE + RT_ROWW), (const float*)(ws + WS_MOD), P.out};
        pg8::gemm_phase<EpiDown, pg8::MoeOrder, true>(C.lds, pg8::Gemm{512, 512, 512}, S, E);
    } SEAM(12);
    if (IN(13)) { MKCTX();
        LAS int* tab = (LAS int*)(C.lds + LDS_MOE_OFF);
        moe_tables<false>(P, C, tab, tab);
        pg8::MoeOrder S; S.tile0 = tab[1]; S.ntiles = tab[0] - tab[1]; S.nN = 8; S.G = G; S.c = cb; S.A = (const char*)(ws + WS_ACT); S.B = (const char*)(ws + WS_WD);
        S.tA = (size_t)256 * 512 * 2; S.tB = (size_t)256 * 512 * 2; S.eB = (size_t)2048 * 512 * 2; S.tile_e = tab + 4; S.rowtok = nullptr;
        EpiDown E{(const int*)(ws + WS_ROUTE + RT_ROWTOK), (const float*)(ws + WS_ROUTE + RT_ROWW), (const float*)(ws + WS_MOD), P.out};
        pg8::gemm_phase<EpiDown, pg8::MoeOrder, true>(C.lds, pg8::Gemm{512, 512, 512}, S, E);
    }
#undef IN
#undef SEAM
}

#ifdef DBG_BUF_OFF
__global__ void dbg_out(const float* x, const unsigned char* ws, float* out) {
    const bf16_t* buf = (const bf16_t*)(ws + (size_t)DBG_BUF_OFF);
    for (size_t i = (size_t)blockIdx.x * 256 + threadIdx.x; i < (size_t)TL * 2048; i += (size_t)gridDim.x * 256) {
        const size_t t = i >> 11, c = i & 2047;
#if defined(DBG_I32)
        out[i] = x[i] + (float)((const int*)buf)[t * DBG_LD + DBG_COL + (c % DBG_W)] * DBG_I32;
#elif defined(DBG_F32)
        out[i] = x[i] + ((const float*)buf)[t * DBG_LD + DBG_COL + (c % DBG_W)];
#else
        { float v_ = bf2f(buf[t * DBG_LD + DBG_COL + (c % DBG_W)]);
#ifdef DBG_SCRUB
          if (!(fabsf(v_) < 1e30f)) v_ = 1000.f;
#endif
          out[i] = x[i] + v_; }
#endif
    }
}
#endif
#ifndef MK_SPLIT
#define MK_SPLIT 0
#endif
extern "C" void kernel_launch(void* const* d_in, const int* in_sizes, int n_in, void* d_out, int out_size, void* d_ws, size_t ws_size, hipStream_t stream) {
    static int grid = 0;
    if (grid == 0) {
        if (n_in != 30 || in_sizes[0] != TL * DM || out_size != TL * DM || ws_size < WS_END) { fprintf(stderr, "kernel_launch: shape/workspace mismatch (n_in %d, in0 %d, out %d, ws %zu < %zu)\n", n_in, n_in > 0 ? in_sizes[0] : -1, out_size, ws_size, (size_t)WS_END); grid = -1; return; }
        int dev = 0, cus = 0, per_cu = 0;
        if (hipGetDevice(&dev) != hipSuccess || hipDeviceGetAttribute(&cus, hipDeviceAttributeMultiprocessorCount, dev) != hipSuccess) { grid = -1; return; }
        if (hipFuncSetAttribute((const void*)mega_fwd, hipFuncAttributeMaxDynamicSharedMemorySize, LDS_BYTES) != hipSuccess) { fprintf(stderr, "kernel_launch: hipFuncSetAttribute failed\n"); grid = -1; return; }
        if (hipOccupancyMaxActiveBlocksPerMultiprocessor(&per_cu, (const void*)mega_fwd, 512, LDS_BYTES) != hipSuccess || per_cu < 1) fprintf(stderr, "kernel_launch: occupancy query says %d\n", per_cu);
        (void)hipGetLastError();
        grid = cus;
    }
    if (grid < 0) return;
    (void)hipMemsetAsync((char*)d_ws + WS_CTL, 0, CTL_ZERO_BYTES, stream);
    Params p{};
    const float** pf = (const float**)&p;
    for (int i = 0; i < 30; ++i) pf[i] = (const float*)d_in[i];
    p.out = (float*)d_out; p.ws = (unsigned char*)d_ws;
#if MK_SPLIT
#ifndef MK_LAST
#define MK_LAST 13
#endif
    for (int k = 0; k < MK_LAST; ++k) { p.ph_lo = k; p.ph_hi = k + 1; hipLaunchKernelGGL(mega_fwd, dim3(grid), dim3(512), LDS_BYTES, stream, p); }
#else
    p.ph_lo = 0; p.ph_hi = N_PHASES; hipLaunchKernelGGL(mega_fwd, dim3(grid), dim3(512), LDS_BYTES, stream, p);
#endif
#ifdef DBG_BUF_OFF
    hipLaunchKernelGGL(dbg_out, dim3(2048), dim3(256), 0, stream, (const float*)d_in[0], (const unsigned char*)d_ws, (float*)d_out);
#endif
    const hipError_t le = hipPeekAtLastError();
    if (le != hipSuccess) fprintf(stderr, "kernel_launch: launch failed: %s\n", hipGetErrorName(le));
}
```

```cpp
#include <hip/hip_runtime.h>
#include <cstdio>
#include <cstdint>

#define LAS __attribute__((address_space(3)))
#define GAS __attribute__((address_space(1)))
typedef unsigned short bf16_t;
typedef short bf16x8 __attribute__((ext_vector_type(8)));
typedef short s16x4 __attribute__((ext_vector_type(4)));
typedef float f32x2 __attribute__((ext_vector_type(2)));
typedef float f32x4 __attribute__((ext_vector_type(4)));
typedef float f32x16 __attribute__((ext_vector_type(16)));
typedef unsigned u32x2 __attribute__((ext_vector_type(2)));
typedef unsigned u32x4 __attribute__((ext_vector_type(4)));

constexpr int DM = 2048, NB = 4, SEQ = 4096, CTXL = 256;
constexpr int TL = NB * SEQ;
constexpr int TCX = NB * CTXL;
constexpr int TA = TL + TCX;
constexpr int D_IN = 11360, N_INP = 11520;
constexpr int NKEY = SEQ + CTXL;
constexpr int NCH = 68;
constexpr float EPSN = 1e-6f;
constexpr int SMW = 1120;
constexpr int SM_AF = 0, SM_AB = 16, SM_CQ = 32, SM_CKV = 544, SM_KR = 1056;
constexpr int MOE_ROWS = 65536;

typedef __bf16 hwbf16x2 __attribute__((ext_vector_type(2)));
__device__ __forceinline__ unsigned cvt_pk_bf16(float lo, float hi) { const f32x2 v = {lo, hi}; return __builtin_bit_cast(unsigned, __builtin_convertvector(v, hwbf16x2)); }
__device__ __forceinline__ float bf_lo(unsigned w) { return __uint_as_float(w << 16); }
__device__ __forceinline__ float bf_hi(unsigned w) { return __uint_as_float(w & 0xffff0000u); }
__device__ __forceinline__ float bf2f(bf16_t h) { return __uint_as_float((unsigned)h << 16); }
__device__ __forceinline__ bf16_t f2bf(float f) { return (bf16_t)(cvt_pk_bf16(f, 0.f) & 0xffffu); }
__device__ __forceinline__ float wave_sum(float v) {
#pragma unroll
    for (int o = 1; o < 64; o <<= 1) v += __shfl_xor(v, o);
    return v;
}
__device__ __forceinline__ float sigmoidf_(float x) { return 1.f / (1.f + __expf(-x)); }
__device__ __forceinline__ float siluf_(float x) { return x / (1.f + __expf(-x)); }
#define LDS_WAIT() asm volatile("s_waitcnt lgkmcnt(0)" ::: "memory")
#define VM_WAIT() asm volatile("s_waitcnt vmcnt(0)" ::: "memory")

#define XB_TMO      128
#define XB_XCNT(j)  (256  + 64 * (j))
#define XB_XSUB(j)  (1280 + 64 * (j))
#define XB_XGEN(j)  (2304 + 64 * (j))
#define XB_TOP      3328
#define XB_TOPGEN   3392
#define XCD_BAR_WORDS 3456
#define XB_SPIN_CAP (1u << 18)

__device__ __forceinline__ unsigned xb_ld(unsigned* p)              { return __hip_atomic_load(p, __ATOMIC_RELAXED, __HIP_MEMORY_SCOPE_AGENT); }
__device__ __forceinline__ unsigned xb_add(unsigned* p, unsigned v) { return __hip_atomic_fetch_add(p, v, __ATOMIC_RELAXED, __HIP_MEMORY_SCOPE_AGENT); }
__device__ __forceinline__ unsigned xb_xcc_id() { return (unsigned)__builtin_amdgcn_s_getreg((3 << 11) | 20) & 0xFu; }
#define XB_SPIN(cond, bar) do { unsigned _sp = 0; while (cond) { __builtin_amdgcn_s_sleep(1); \
    if ((++_sp & 255u) == 0u) { if (xb_ld(&(bar)[XB_TMO])) break; if (_sp > XB_SPIN_CAP) { atomicAdd(&(bar)[XB_TMO], 1u); break; } } } } while (0)

struct XcdBarrier { unsigned* bar; unsigned x; volatile LAS unsigned* st; };

__device__ __forceinline__ XcdBarrier xcd_barrier_post(unsigned* bar, volatile LAS unsigned* st) {
    XcdBarrier b; b.bar = bar; b.x = xb_xcc_id(); b.st = st;
    if (threadIdx.x == 0) (void)xb_add(&bar[XB_XCNT(b.x)], 1u);
    return b;
}
__device__ __forceinline__ void xcd_barrier_complete(unsigned* bar, unsigned x, unsigned& nloc, unsigned& nx) {
    const unsigned G = gridDim.x * gridDim.y * gridDim.z;
    unsigned sum, cnt, mine, sp = 0u;
    for (;;) {
        sum = 0u; cnt = 0u; mine = 0u;
#pragma unroll
        for (unsigned j = 0; j < 16; ++j) { const unsigned c = xb_ld(&bar[XB_XCNT(j)]); sum += c; cnt += (c > 0u) ? 1u : 0u; mine = (j == x) ? c : mine; }
        if (sum == G) break;
        __builtin_amdgcn_s_sleep(1);
        if ((++sp & 255u) == 0u) { if (xb_ld(&bar[XB_TMO])) break; if (sp > XB_SPIN_CAP) { atomicAdd(&bar[XB_TMO], 1u); break; } }
    }
    nloc = mine > 0u ? mine : 1u; nx = cnt > 0u ? cnt : 1u;
}
__device__ __forceinline__ void xcd_barrier(const XcdBarrier& b) {
    asm volatile("s_waitcnt vmcnt(0)" ::: "memory");
    __syncthreads();
    if (threadIdx.x == 0) {
        unsigned* bar = b.bar;
        __builtin_amdgcn_s_waitcnt(0);
        unsigned nloc = b.st[0], nx = b.st[1];
        if (nloc == 0u) { xcd_barrier_complete(bar, b.x, nloc, nx); b.st[0] = nloc; b.st[1] = nx; }
        const unsigned old = xb_add(&bar[XB_XSUB(b.x)], 1u);
        const unsigned gen = old / nloc;
        if (old + 1u == (gen + 1u) * nloc) {
            __builtin_amdgcn_fence(__ATOMIC_RELEASE, "agent");
            asm volatile("s_waitcnt vmcnt(0)" ::: "memory");
            const unsigned og = xb_add(&bar[XB_TOP], 1u);
            const unsigned tg = og / nx;
            if (og + 1u == (tg + 1u) * nx) xb_add(&bar[XB_TOPGEN], 1u);
            else XB_SPIN(xb_ld(&bar[XB_TOPGEN]) == tg, bar);
            __builtin_amdgcn_fence(__ATOMIC_ACQUIRE, "agent");
            xb_add(&bar[XB_XGEN(b.x)], 1u);
            asm volatile("s_waitcnt vmcnt(0)" ::: "memory");
        } else {
            XB_SPIN(xb_ld(&bar[XB_XGEN(b.x)]) == gen, bar);
            __builtin_amdgcn_fence(__ATOMIC_ACQUIRE, "agent");
            asm volatile("s_waitcnt vmcnt(0)" ::: "memory");
        }
    }
    __syncthreads();
}

namespace pg8 {
constexpr int BM = 256, BK = 64, HALF = 128, HTB = HALF * BK * 2, STAGE_BYTES = 8 * HTB, NXCD = 8, WGM = 8;
__host__ __device__ __forceinline__ int lds_byte(int r, int c) { const int st = (r >> 4) * 2 + (c >> 5), rr = r & 15, cc = c & 31, ob = rr * 64 + cc * 2; return st * 1024 + (ob ^ (((ob >> 9) & 1) << 5)); }
__host__ __device__ __forceinline__ void stage_rc(int b, int& R, int& C) { const int st = b / 1024, sb = b % 1024, swz = sb ^ (((sb >> 9) & 1) << 5); R = (st >> 1) * 16 + swz / 64; C = (st & 1) * 32 + (swz % 64) / 2; }
__host__ __device__ __forceinline__ int perm32(int rho) { const int n = rho >> 4, i = rho & 15; return 8 * (i >> 2) + 4 * n + (i & 3); }

struct Unit { int pm, pn, e, half; };
struct Gemm { int lda, ldb, K; };

struct DenseOrder {
    int nM, nN, nwg, G, c; const char* A; const char* B; size_t tA, tB;
    __device__ void init(const bf16_t* A_, const bf16_t* B_, int M, int N, int lda, int ldb, int G_, int c_) { nM = M / BM; nN = N / BM; nwg = nM * nN; G = G_; c = c_; A = (const char*)A_; B = (const char*)B_; tA = (size_t)BM * lda * 2; tB = (size_t)BM * ldb * 2; }
    __device__ bool next(int i, Unit& u) const {
        const long L = (long)i * G + c; if (L >= nwg) return false;
        int wgid = (int)L; { const int q = nwg / NXCD, r = nwg % NXCD, xcd = wgid % NXCD, off = wgid / NXCD; wgid = (xcd < r ? xcd * (q + 1) : r * (q + 1) + (xcd - r) * q) + off; }
        const int nig = WGM * nN, gid = wgid / nig, fm = gid * WGM, gsz = (nM - fm) < WGM ? (nM - fm) : WGM;
        u.pm = fm + ((wgid % nig) % gsz); u.pn = (wgid % nig) / gsz; u.e = 0; u.half = 0; return true;
    }
    __device__ __forceinline__ void origin(const Unit& u, const char*& a, const char*& b) const { a = A + (size_t)u.pm * tA; b = B + (size_t)u.pn * tB; }
};
struct DualOrder {
    DenseOrder D; size_t koff; int r0, r1;
    __device__ bool next(int i, Unit& u) const { const int r = (i >> 1) + r0; if (r >= r1 || !D.next(r, u)) return false; u.e = i & 1; return true; }
    __device__ __forceinline__ void origin(const Unit& u, const char*& a, const char*& b) const { D.origin(u, a, b); a += (size_t)u.e * koff; b += (size_t)u.e * koff; }
};
struct MoeOrder {
    int tile0, ntiles, nN, G, c; const char* A; const char* B; size_t tA, tB, eB; const LAS int* tile_e; const int* rowtok;
    __device__ bool next(int i, Unit& u) const {
        int t, pn;
        if (G == 256) {
            const int x = c & 7, j = c >> 3, per = 32 / nN;
            t = i * (8 * per) + x * per + j / nN; pn = j % nN; if (t >= ntiles) return false;
        } else { const long L = (long)i * G + c; if (L >= (long)ntiles * nN) return false; t = (int)(L / nN); pn = (int)(L % nN); }
        u.pm = tile0 + t; u.pn = pn; const int te = tile_e[u.pm]; u.e = te & 63; u.half = te >> 6; return true;
    }
    __device__ __forceinline__ void origin(const Unit& u, const char*& a, const char*& b) const { a = A + (size_t)u.pm * tA; b = B + (size_t)u.e * eB + (size_t)u.pn * tB; }
};

template <class Epi, class Sched, bool ALIGN_EPI, bool GATHER = false>
__device__ __forceinline__ void gemm_phase(LAS unsigned char* lds, const Gemm g, const Sched& S, const Epi& E) {
    int tid_ = threadIdx.x; asm volatile("" : "+v"(tid_));
    const int tid = tid_, wid = __builtin_amdgcn_readfirstlane(tid >> 6), lane = tid & 63, wr = wid >> 2, wc = wid & 3, fr = lane & 15, fq = lane >> 4;
    const int K = g.K, nt = K / BK;
    unsigned voffA[2], voffB[2]; int gR[2], gC[2];
#pragma unroll
    for (int i = 0; i < 2; ++i) { int R, C; stage_rc(tid * 16 + i * 8192, R, C); const int Rb = Epi::PERM ? ((R & ~31) + perm32(R & 31)) : R;
        voffA[i] = (unsigned)(R * g.lda + C) * 2u; voffB[i] = (unsigned)(Rb * g.ldb + C) * 2u; gR[i] = R; gC[i] = C; }
    unsigned gc[2][2], gn[2][2];
#define PG8_GOFF(dst, u_) do { if constexpr (GATHER) { _Pragma("unroll") for (int h_ = 0; h_ < 2; ++h_) _Pragma("unroll") for (int i_ = 0; i_ < 2; ++i_) { \
        int tk_ = S.rowtok[(u_).pm * 256 + h_ * 128 + gR[i_]]; tk_ = tk_ < 0 ? 0 : tk_; dst[h_][i_] = (unsigned)(tk_ * g.lda + gC[i_]) * 2u; } } } while (0)
#define PG8_STAGE_A(bufoff, gbase, h_, nx_) do { if constexpr (GATHER) { _Pragma("unroll") for (int _i = 0; _i < 2; ++_i) \
        __builtin_amdgcn_global_load_lds((const unsigned*)((const char*)(gbase) + ((nx_) ? gn[h_][_i] : gc[h_][_i])), (LAS unsigned*)(lds + (bufoff) + ldsw + _i * 8192), 16, 0, 0); } \
      else { PG8_STAGE(bufoff, (gbase) + (h_) * hstepA, voffA); } } while (0)
    const size_t kstep = (size_t)(BK * 2);
    const size_t hstepA = (size_t)HALF * g.lda * 2, hstepB = (size_t)HALF * g.ldb * 2;
    const unsigned ldsw = (unsigned)wid * 1024u;
    const int aoff = lds_byte(wr * 64 + fr, fq * 8), boff = lds_byte(wc * 32 + fr, fq * 8);
#define PG8_SA(b, h) (((b) * 2 + (h)) * HTB)
#define PG8_SB(b, h) ((4 + (b) * 2 + (h)) * HTB)
#define PG8_STAGE(bufoff, gbase, voff) do { _Pragma("unroll") for (int _i = 0; _i < 2; ++_i) \
        __builtin_amdgcn_global_load_lds((const unsigned*)((const char*)(gbase) + (voff)[_i]), (LAS unsigned*)(lds + (bufoff) + ldsw + _i * 8192), 16, 0, 0); } while (0)
#define PG8_LDA(dst, b, h) do { _Pragma("unroll") for (int m = 0; m < 4; ++m) _Pragma("unroll") for (int k = 0; k < 2; ++k) dst[m][k] = *(const LAS bf16x8*)(lds + PG8_SA(b, h) + aoff + m * 2048 + k * 1024); } while (0)
#define PG8_LDB(dst, b, h) do { _Pragma("unroll") for (int n = 0; n < 2; ++n) _Pragma("unroll") for (int k = 0; k < 2; ++k) dst[n][k] = *(const LAS bf16x8*)(lds + PG8_SB(b, h) + boff + n * 2048 + k * 1024); } while (0)
#define PG8_MMA(ai, bj, At, Bt) do { __builtin_amdgcn_s_setprio(1); _Pragma("unroll") for (int m = 0; m < 4; ++m) _Pragma("unroll") for (int n = 0; n < 2; ++n) _Pragma("unroll") for (int k = 0; k < 2; ++k) \
        acc[ai][bj][m][n] = __builtin_amdgcn_mfma_f32_16x16x32_bf16(Bt[n][k], At[m][k], acc[ai][bj][m][n], 0, 0, 0); __builtin_amdgcn_s_setprio(0); } while (0)
#define PG8_WAIT_V(n) asm volatile("s_waitcnt vmcnt(" #n ")" ::: "memory")
#define PG8_WAIT_L(n) asm volatile("s_waitcnt lgkmcnt(" #n ")" ::: "memory")
#define PG8_BAR __builtin_amdgcn_s_barrier()
#define PG8_SCHED __builtin_amdgcn_sched_barrier(0)
    Unit cur, nxt; int ui = 0;
    if (!S.next(0, cur)) return;
    f32x4 acc[2][2][4][2];
#pragma unroll
    for (int a = 0; a < 2; ++a)
#pragma unroll
        for (int b = 0; b < 2; ++b)
#pragma unroll
            for (int m = 0; m < 4; ++m)
#pragma unroll
                for (int n = 0; n < 2; ++n) acc[a][b][m][n] = (f32x4){0.f, 0.f, 0.f, 0.f};
    bf16x8 At[4][2], B0[2][2], B1[2][2];
    const char* cA; const char* cB; S.origin(cur, cA, cB);
    PG8_GOFF(gc, cur);
    PG8_STAGE(PG8_SB(0, 0), cB, voffB); PG8_STAGE(PG8_SB(0, 1), cB + hstepB, voffB); PG8_STAGE_A(PG8_SA(0, 0), cA, 0, false); PG8_STAGE_A(PG8_SA(0, 1), cA, 1, false);
    if (wr == 1) PG8_BAR;
    PG8_WAIT_V(2); PG8_BAR;
    PG8_STAGE(PG8_SB(1, 0), cB + kstep, voffB); PG8_STAGE_A(PG8_SA(1, 0), cA + kstep, 0, false); PG8_STAGE(PG8_SB(1, 1), cB + hstepB + kstep, voffB);
    PG8_WAIT_V(6); PG8_BAR;
    for (;;) {
        const bool has_next = S.next(ui + 1, nxt);
        const char* nA = cA; const char* nB = cB; if (has_next) { S.origin(nxt, nA, nB); PG8_GOFF(gn, nxt); } else { if constexpr (GATHER) { _Pragma("unroll") for (int h_ = 0; h_ < 2; ++h_) _Pragma("unroll") for (int i_ = 0; i_ < 2; ++i_) gn[h_][i_] = gc[h_][i_]; } }
        for (int t = 0; t < nt; t += 2) {
            const bool last = (t == nt - 2);
            const char* a1 = cA + (size_t)(t + 1) * kstep;
            const char* a2 = last ? nA : cA + (size_t)(t + 2) * kstep; const char* b2 = last ? nB : cB + (size_t)(t + 2) * kstep;
            const char* a3 = a2 + kstep; const char* b3 = b2 + kstep;
            PG8_LDB(B0, 0, 0); PG8_LDB(B1, 0, 1); PG8_SCHED; PG8_LDA(At, 0, 0); PG8_STAGE_A(PG8_SA(1, 1), a1, 1, false);
            PG8_WAIT_V(8); PG8_WAIT_L(0); PG8_BAR; PG8_MMA(0, 0, At, B0); PG8_MMA(0, 1, At, B1); PG8_BAR; PG8_SCHED;
            PG8_LDA(At, 0, 1); PG8_STAGE(PG8_SB(0, 0), b2, voffB); PG8_STAGE(PG8_SB(0, 1), b2 + hstepB, voffB); PG8_STAGE_A(PG8_SA(0, 0), a2, 0, last);
            PG8_WAIT_V(8); PG8_WAIT_L(0); PG8_BAR; if (!cur.half) { PG8_MMA(1, 0, At, B0); PG8_MMA(1, 1, At, B1); } PG8_BAR; PG8_SCHED;
            PG8_LDB(B0, 1, 0); PG8_LDB(B1, 1, 1); PG8_SCHED; PG8_LDA(At, 1, 0); PG8_STAGE_A(PG8_SA(0, 1), a2, 1, last);
            PG8_WAIT_V(8); PG8_WAIT_L(0); PG8_BAR; PG8_MMA(0, 0, At, B0); PG8_MMA(0, 1, At, B1); PG8_BAR; PG8_SCHED;
            PG8_LDA(At, 1, 1); PG8_STAGE(PG8_SB(1, 0), b3, voffB); PG8_STAGE(PG8_SB(1, 1), b3 + hstepB, voffB); PG8_STAGE_A(PG8_SA(1, 0), a3, 0, last);
            PG8_WAIT_V(8); PG8_WAIT_L(0); PG8_BAR; if (!cur.half) { PG8_MMA(1, 0, At, B0); PG8_MMA(1, 1, At, B1); } PG8_BAR; PG8_SCHED;
        }
        if constexpr (ALIGN_EPI) { if (wr == 0) PG8_BAR; }
        E(acc, cur, wr, wc, fr, fq);
        if (!has_next) break;
        if (!(Epi::KEEP_ACC && cur.e == 0)) {
#pragma unroll
        for (int a = 0; a < 2; ++a)
#pragma unroll
            for (int b = 0; b < 2; ++b)
#pragma unroll
                for (int m = 0; m < 4; ++m)
#pragma unroll
                    for (int n = 0; n < 2; ++n) acc[a][b][m][n] = (f32x4){0.f, 0.f, 0.f, 0.f};
        }
        cur = nxt; cA = nA; cB = nB; ++ui;
        if constexpr (GATHER) { _Pragma("unroll") for (int h_ = 0; h_ < 2; ++h_) _Pragma("unroll") for (int i_ = 0; i_ < 2; ++i_) gc[h_][i_] = gn[h_][i_]; }
        if constexpr (ALIGN_EPI) { if (wr == 1) PG8_BAR; }
    }
    PG8_WAIT_V(0);
    if constexpr (!ALIGN_EPI) { if (wr == 0) PG8_BAR; }
    PG8_BAR;
#undef PG8_SA
#undef PG8_SB
#undef PG8_STAGE
#undef PG8_STAGE_A
#undef PG8_GOFF
#undef PG8_LDA
#undef PG8_LDB
#undef PG8_MMA
#undef PG8_WAIT_V
#undef PG8_WAIT_L
#undef PG8_BAR
#undef PG8_SCHED
}
}
constexpr size_t MiB = 1u << 20;
constexpr size_t WS_CTL = 0;
constexpr size_t CTL_ZERO_BYTES = 64 * 1024;
constexpr size_t WS_ROPE = 154 * MiB + 512 * 1024;
constexpr int CW_BAR = 1024;
constexpr int CW_CNT = 8192;
constexpr size_t WS_MOD  = 1 * MiB;
constexpr size_t WS_WRT  = 1 * MiB + 512 * 1024;
constexpr size_t WS_WIN  = 3 * MiB;
constexpr size_t WS_ATT  = 3 * MiB;
constexpr size_t WS_DE   = 21 * MiB;
constexpr size_t WS_ROUTE= 24 * MiB;
constexpr size_t WS_SSKR = 25 * MiB;
constexpr size_t WS_RSTD = 26 * MiB;
constexpr size_t WS_PS   = 27 * MiB;
constexpr size_t WS_WUQ  = 48 * MiB;
constexpr size_t WS_WUKV = 52 * MiB;
constexpr size_t WS_WCAT = 56 * MiB;
constexpr size_t WS_WOUT = 72 * MiB;
constexpr size_t WS_SM   = 80 * MiB;
constexpr size_t WS_QK   = 156 * MiB;
constexpr size_t WS_H    = 224 * MiB;
constexpr size_t WS_V    = 292 * MiB;
constexpr size_t WS_YCAT = 224 * MiB;
constexpr size_t WS_R    = 360 * MiB;
constexpr size_t WS_GAB  = 424 * MiB;
constexpr size_t WS_CQN  = 552 * MiB;
constexpr size_t WS_CKVN = 569 * MiB;
constexpr size_t WS_KET  = 586 * MiB;
constexpr size_t WS_Y    = 586 * MiB;
constexpr size_t WS_QRAW = 654 * MiB;
constexpr size_t WS_VM   = 750 * MiB;
constexpr size_t WS_OF   = 818 * MiB;
constexpr size_t WS_OB   = 882 * MiB;
constexpr size_t WS_KM   = 946 * MiB;
constexpr size_t WS_WGU  = 654 * MiB;
constexpr size_t WS_WD   = 910 * MiB;
constexpr size_t WS_H2S  = 156 * MiB;
constexpr size_t WS_ACT  = 416 * MiB;
constexpr size_t WS_END  = 1048 * MiB;
constexpr size_t RT_E = 0, RT_P = 128 * 1024, RT_W = 256 * 1024, RT_RSTD = 384 * 1024, RT_ROWTOK = 512 * 1024, RT_ROWW = 768 * 1024;

constexpr int LDS_BYTES = 147456;
constexpr int LDS_CTL_OFF = 145408;
constexpr int LDS_MOE_OFF = LDS_CTL_OFF + 64;

struct Params {
    const float *x, *c, *ctx, *c_ctx, *w_mod, *b_mod, *norm1_g, *norm2_g, *w_in, *w_decay_f, *b_decay_f, *w_decay_b, *b_decay_b, *gla_norm_g,
                *q_a_norm_g, *w_uq, *kv_a_norm_g, *w_ukv, *q_norm_g, *k_norm_g, *w_o_gla, *w_o_mla, *w_out, *w_rg, *b_rg, *w_re, *b_re, *w_eg, *w_eu, *w_ed;
    float* out; unsigned char* ws; int ph_lo, ph_hi;
};

using pg8::Unit;
__device__ __forceinline__ u32x4 pack8(const f32x4& a, const f32x4& b) { u32x4 w; w.x = cvt_pk_bf16(a[0], a[1]); w.y = cvt_pk_bf16(a[2], a[3]); w.z = cvt_pk_bf16(b[0], b[1]); w.w = cvt_pk_bf16(b[2], b[3]); return w; }

struct EpiProj { static constexpr bool PERM = true, KEEP_ACC = false;
    bf16_t *QK, *V, *R, *GAB; float* SM;
    __device__ __forceinline__ void operator()(f32x4 (&acc)[2][2][4][2], const Unit& u, int wr, int wc, int fr, int fq) const {
#pragma unroll
        for (int bj = 0; bj < 2; ++bj) {
            const int c = u.pn * 256 + bj * 128 + wc * 32 + 8 * fq;
            bf16_t* dst = nullptr; int ld = 0; bool lat_only = false, f32dst = false;
            if (c < 2048) { dst = QK + c; ld = 2048; }
            else if (c < 4096) { dst = V + (c - 2048); ld = 2048; }
            else if (c < 6144) { dst = R + (c - 4096); ld = 2048; lat_only = true; }
            else if (c < 7264) { f32dst = true; }
            else if (c < D_IN) { dst = GAB + (c - 7264); ld = 4096; lat_only = true; }
            else continue;
#pragma unroll
            for (int ai = 0; ai < 2; ++ai)
#pragma unroll
                for (int m = 0; m < 4; ++m) {
                    const int row = u.pm * 256 + ai * 128 + wr * 64 + m * 16 + fr;
                    if (lat_only && row >= TL) continue;
                    if (f32dst) { float* p = SM + (size_t)row * SMW + (c - 6144); *(f32x4*)p = acc[ai][bj][m][0]; *(f32x4*)(p + 4) = acc[ai][bj][m][1]; }
                    else *(u32x4*)(dst + (size_t)row * ld) = pack8(acc[ai][bj][m][0], acc[ai][bj][m][1]);
                }
        }
    }
};
struct EpiPlain { static constexpr bool PERM = true, KEEP_ACC = false;
    bf16_t* O; int ldc;
    __device__ __forceinline__ void operator()(f32x4 (&acc)[2][2][4][2], const Unit& u, int wr, int wc, int fr, int fq) const {
#pragma unroll
        for (int bj = 0; bj < 2; ++bj) { const int c = u.pn * 256 + bj * 128 + wc * 32 + 8 * fq;
#pragma unroll
            for (int ai = 0; ai < 2; ++ai)
#pragma unroll
                for (int m = 0; m < 4; ++m) { const int row = u.pm * 256 + ai * 128 + wr * 64 + m * 16 + fr;
                    *(u32x4*)(O + (size_t)row * ldc + c) = pack8(acc[ai][bj][m][0], acc[ai][bj][m][1]); } }
    }
};
struct EpiUkv { static constexpr bool PERM = true, KEEP_ACC = false;
    bf16_t *KM, *VM; const float* SSKR; float* RSTD; const float* kng; LAS float* SS;
    __device__ __forceinline__ void operator()(f32x4 (&acc)[2][2][4][2], const Unit& u, int wr, int wc, int fr, int fq) const {
        const int cw = wc * 32 + 8 * fq;
#pragma unroll
        for (int ai = 0; ai < 2; ++ai)
#pragma unroll
            for (int m = 0; m < 4; ++m) { const f32x4 a = acc[ai][0][m][0], b = acc[ai][0][m][1];
                float s = (a[0] * a[0] + a[1] * a[1]) + (a[2] * a[2] + a[3] * a[3]) + (b[0] * b[0] + b[1] * b[1]) + (b[2] * b[2] + b[3] * b[3]);
                s += __shfl_xor(s, 16); s += __shfl_xor(s, 32);
                if (fq == 0) SS[(ai * 128 + wr * 64 + m * 16 + fr) * 4 + wc] = s; }
        asm volatile("s_waitcnt lgkmcnt(0)" ::: "memory"); __builtin_amdgcn_s_barrier(); asm volatile("" ::: "memory");
        const f32x4 g0 = *(const f32x4*)(kng + cw), g1 = *(const f32x4*)(kng + cw + 4);
#pragma unroll
        for (int ai = 0; ai < 2; ++ai)
#pragma unroll
            for (int m = 0; m < 4; ++m) { const int rl = ai * 128 + wr * 64 + m * 16 + fr, row = u.pm * 256 + rl;
                int b, key; if (row < TL) { b = row >> 12; key = row & 4095; } else { const int r2 = row - TL; b = r2 >> 8; key = SEQ + (r2 & 255); }
                const f32x4 p = *(const LAS f32x4*)(SS + rl * 4);
                const float rstd = 1.f / sqrtf(((p[0] + p[1]) + (p[2] + p[3]) + SSKR[row]) * (1.f / 192.f) + EPSN);
                if (wc == 0 && fq == 0) RSTD[(size_t)row * 16 + u.pn] = rstd;
                *(u32x4*)(KM + ((size_t)(b * 16 + u.pn) * NKEY + key) * 192 + cw) = pack8(acc[ai][0][m][0] * rstd * g0, acc[ai][0][m][1] * rstd * g1);
                *(u32x4*)(VM + ((size_t)(b * 16 + u.pn) * NKEY + key) * 128 + cw) = pack8(acc[ai][1][m][0], acc[ai][1][m][1]); }
    }
};
struct EpiMerge { static constexpr bool PERM = true, KEEP_ACC = true;
    const bf16_t* GAB; bf16_t* Y;
    __device__ __forceinline__ void mid(f32x4 (&acc)[2][2][4][2], const Unit& u, int wr, int wc, int fr, int fq) const {
#pragma unroll
        for (int bj = 0; bj < 2; ++bj) { const int c = u.pn * 256 + bj * 128 + wc * 32 + 8 * fq;
#pragma unroll
            for (int ai = 0; ai < 2; ++ai)
#pragma unroll
                for (int m = 0; m < 4; ++m) { const int row = u.pm * 256 + ai * 128 + wr * 64 + m * 16 + fr;
                    const u32x4 ga = *(const u32x4*)(GAB + (size_t)row * 4096 + c), gb = *(const u32x4*)(GAB + (size_t)row * 4096 + 2048 + c);
#pragma unroll
                    for (int j = 0; j < 4; ++j) {
                        const float a0 = bf_lo(ga[j]), a1 = bf_hi(ga[j]), b0 = bf_lo(gb[j]), b1 = bf_hi(gb[j]);
                        const float r0 = (1.f + __expf(-b0)) / (1.f + __expf(-a0)), r1 = (1.f + __expf(-b1)) / (1.f + __expf(-a1));
                        acc[ai][bj][m][j >> 1][(j & 1) * 2 + 0] *= r0; acc[ai][bj][m][j >> 1][(j & 1) * 2 + 1] *= r1; }
                    asm volatile("" : "+v"(acc[ai][bj][m][0]), "+v"(acc[ai][bj][m][1]) :: "memory");
                } }
    }
    __device__ __forceinline__ void operator()(f32x4 (&acc)[2][2][4][2], const Unit& u, int wr, int wc, int fr, int fq) const {
        if (u.e == 0) { mid(acc, u, wr, wc, fr, fq); return; }
#pragma unroll
        for (int bj = 0; bj < 2; ++bj) { const int c = u.pn * 256 + bj * 128 + wc * 32 + 8 * fq;
#pragma unroll
            for (int ai = 0; ai < 2; ++ai)
#pragma unroll
                for (int m = 0; m < 4; ++m) { const int row = u.pm * 256 + ai * 128 + wr * 64 + m * 16 + fr;
                    const u32x4 gb = *(const u32x4*)(GAB + (size_t)row * 4096 + 2048 + c);
                    f32x4 v0 = acc[ai][bj][m][0], v1 = acc[ai][bj][m][1];
                    v0[0] *= sigmoidf_(bf_lo(gb[0])); v0[1] *= sigmoidf_(bf_hi(gb[0])); v0[2] *= sigmoidf_(bf_lo(gb[1])); v0[3] *= sigmoidf_(bf_hi(gb[1]));
                    v1[0] *= sigmoidf_(bf_lo(gb[2])); v1[1] *= sigmoidf_(bf_hi(gb[2])); v1[2] *= sigmoidf_(bf_lo(gb[3])); v1[3] *= sigmoidf_(bf_hi(gb[3]));
                    *(u32x4*)(Y + (size_t)row * 2048 + c) = pack8(v0, v1); } }
    }
};
struct EpiOut { static constexpr bool PERM = false, KEEP_ACC = false;
    const float* X; const float* MOD; float* O; float* PS;
    __device__ __forceinline__ void operator()(f32x4 (&acc)[2][2][4][2], const Unit& u, int wr, int wc, int fr, int fq) const {
        const int b = u.pm >> 4;
        float ssq[2][4];
#pragma unroll
        for (int ai = 0; ai < 2; ++ai)
#pragma unroll
            for (int m = 0; m < 4; ++m) ssq[ai][m] = 0.f;
#pragma unroll
        for (int bj = 0; bj < 2; ++bj) {
            const int c0 = u.pn * 256 + bj * 128 + wc * 32 + 4 * fq;
            const f32x4 gt0 = *(const f32x4*)(MOD + (size_t)b * 12288 + 4096 + c0), gt1 = *(const f32x4*)(MOD + (size_t)b * 12288 + 4096 + c0 + 16);
#pragma unroll
            for (int ai = 0; ai < 2; ++ai) {
                f32x4 xv[4][2];
#pragma unroll
                for (int m = 0; m < 4; ++m) { const int row = u.pm * 256 + ai * 128 + wr * 64 + m * 16 + fr;
                    xv[m][0] = __builtin_nontemporal_load((const f32x4*)(X + (size_t)row * 2048 + c0)); xv[m][1] = __builtin_nontemporal_load((const f32x4*)(X + (size_t)row * 2048 + c0 + 16)); }
#pragma unroll
                for (int m = 0; m < 4; ++m) { const int row = u.pm * 256 + ai * 128 + wr * 64 + m * 16 + fr;
                    const f32x4 o0 = xv[m][0] + gt0 * acc[ai][bj][m][0], o1 = xv[m][1] + gt1 * acc[ai][bj][m][1];
                    ssq[ai][m] += (o0[0] * o0[0] + o0[1] * o0[1]) + (o0[2] * o0[2] + o0[3] * o0[3]);
                    ssq[ai][m] += (o1[0] * o1[0] + o1[1] * o1[1]) + (o1[2] * o1[2] + o1[3] * o1[3]);
                    *(f32x4*)(O + (size_t)row * 2048 + c0) = o0; *(f32x4*)(O + (size_t)row * 2048 + c0 + 16) = o1; } } }
#pragma unroll
        for (int ai = 0; ai < 2; ++ai)
#pragma unroll
            for (int m = 0; m < 4; ++m) { float s = ssq[ai][m]; s += __shfl_xor(s, 16); s += __shfl_xor(s, 32);
                if (fq == 0) PS[(size_t)(u.pm * 256 + ai * 128 + wr * 64 + m * 16 + fr) * 32 + u.pn * 4 + wc] = s; }
    }
};
struct EpiGU { static constexpr bool PERM = true, KEEP_ACC = false;
    bf16_t* ACT;
    __device__ __forceinline__ void operator()(f32x4 (&acc)[2][2][4][2], const Unit& u, int wr, int wc, int fr, int fq) const {
        const int c = u.pn * 128 + wc * 32 + 8 * fq;
#pragma unroll
        for (int ai = 0; ai < 2; ++ai)
#pragma unroll
            for (int m = 0; m < 4; ++m) { const int row = u.pm * 256 + ai * 128 + wr * 64 + m * 16 + fr;
                f32x4 v0, v1;
#pragma unroll
                for (int q = 0; q < 4; ++q) { v0[q] = siluf_(acc[ai][0][m][0][q]) * acc[ai][1][m][0][q]; v1[q] = siluf_(acc[ai][0][m][1][q]) * acc[ai][1][m][1][q]; }
                *(u32x4*)(ACT + (size_t)row * 512 + c) = pack8(v0, v1); }
    }
};
struct EpiDown { static constexpr bool PERM = false, KEEP_ACC = false;
    const int* ROWTOK; const float* ROWW; const float* MOD; float* O;
    __device__ __forceinline__ void operator()(f32x4 (&acc)[2][2][4][2], const Unit& u, int wr, int wc, int fr, int fq) const {
        int tok[2][4]; float w[2][4];
#pragma unroll
        for (int ai = 0; ai < 2; ++ai)
#pragma unroll
            for (int m = 0; m < 4; ++m) { const int row = u.pm * 256 + ai * 128 + wr * 64 + m * 16 + fr; tok[ai][m] = ROWTOK[row]; w[ai][m] = ROWW[row]; }
#pragma unroll
        for (int ai = 0; ai < 2; ++ai)
#pragma unroll
            for (int m = 0; m < 4; ++m) {
                const int tk = tok[ai][m]; if (tk < 0) continue;
                const float* gp = MOD + (size_t)(tk >> 12) * 12288 + 10240 + u.pn * 256 + wc * 32 + 4 * fq;
                float* op = O + (size_t)tk * 2048 + u.pn * 256 + wc * 32 + 4 * fq;
                f32x4 gt[2][2], ov[2][2];
#pragma unroll
                for (int bj = 0; bj < 2; ++bj)
#pragma unroll
                    for (int n = 0; n < 2; ++n) { gt[bj][n] = *(const f32x4*)(gp + bj * 128 + 16 * n); ov[bj][n] = *(const f32x4*)(op + bj * 128 + 16 * n); }
#pragma unroll
                for (int bj = 0; bj < 2; ++bj)
#pragma unroll
                    for (int n = 0; n < 2; ++n) *(f32x4*)(op + bj * 128 + 16 * n) = ov[bj][n] + gt[bj][n] * (acc[ai][bj][m][n] * w[ai][m]);
            }
    }
};
struct Ctx { int tid, lane, wave, gw, ngw; LAS unsigned char* lds; };

struct TrItem { const float* W; int ldw, k0, n0; bf16_t* dst; int ldt; };
__device__ __forceinline__ void tr_load(f32x4 (&v)[8], const TrItem& t, int lane) {
    const int c4 = lane & 7, r8 = lane >> 3;
#pragma unroll
    for (int i = 0; i < 8; ++i) v[i] = __builtin_nontemporal_load((const f32x4*)(t.W + (size_t)(t.k0 + 8 * i + r8) * t.ldw + t.n0 + 4 * c4));
}
__device__ __forceinline__ void tr_store(const f32x4 (&v)[8], const TrItem& t, LAS float* scr, int lane) {
    { const int c4 = lane & 7, r8 = lane >> 3;
#pragma unroll
      for (int i = 0; i < 8; ++i) { LAS float* d = scr + (8 * i + r8) * 33 + 4 * c4; d[0] = v[i][0]; d[1] = v[i][1]; d[2] = v[i][2]; d[3] = v[i][3]; } }
    LDS_WAIT(); asm volatile("" ::: "memory");
    const int c = lane & 7;
#pragma unroll
    for (int j = 0; j < 4; ++j) { const int n = (lane >> 3) + 8 * j; const LAS float* s = scr + (8 * c) * 33 + n;
        u32x4 o; o.x = cvt_pk_bf16(s[0 * 33], s[1 * 33]); o.y = cvt_pk_bf16(s[2 * 33], s[3 * 33]); o.z = cvt_pk_bf16(s[4 * 33], s[5 * 33]); o.w = cvt_pk_bf16(s[6 * 33], s[7 * 33]);
        __builtin_nontemporal_store(o, (u32x4*)(t.dst + (size_t)n * t.ldt + 8 * c)); }
    LDS_WAIT(); asm volatile("" ::: "memory");
}
__device__ __forceinline__ TrItem conv_item(const float* W, int K, int N, bf16_t* WT, int ldt, int coloff, int it) {
    const int nblk = N / 32, kb = it / nblk, nb = it % nblk;
    return TrItem{W, N, 64 * kb, 32 * nb, WT + (size_t)(32 * nb) * ldt + coloff + 64 * kb, ldt};
}

__device__ __forceinline__ void phase0(const Params& P, const Ctx& C) {
    unsigned char* ws = P.ws;
    {
        LAS float* sc = (LAS float*)C.lds;
        LAS float* red = (LAS float*)(C.lds + 40960);
        float* MOD = (float*)(ws + WS_MOD);
        for (int i = C.tid; i < 5 * 2048; i += 512) { const int r = i >> 11, k = i & 2047; const float v = (r < 4) ? P.c[r * 2048 + k] : P.c_ctx[k]; sc[i] = v / (1.f + expf(-v)); }
        __syncthreads();
        for (int cb_ = blockIdx.x; cb_ < 256; cb_ += gridDim.x) {
            const int chunk = ((cb_ & 7) * 16 + ((cb_ >> 3) >> 1)) * 2 + ((cb_ >> 3) & 1);
            const int n0 = chunk * 48, ks = C.tid / 12, cg = C.tid % 12;
            if (C.tid < 504) {
                f32x4 a0 = {0, 0, 0, 0}, a1 = a0, a2 = a0, a3 = a0, a4 = a0;
#pragma unroll 8
                for (int k = ks; k < 2048; k += 42) {
                    const f32x4 w = *(const f32x4*)(P.w_mod + (size_t)k * 12288 + n0 + cg * 4);
                    a0 += w * sc[k]; a1 += w * sc[2048 + k]; a2 += w * sc[4096 + k]; a3 += w * sc[6144 + k]; a4 += w * sc[8192 + k];
                }
                LAS float* rp = red + ks * 240 + cg * 4;
#pragma unroll
                for (int q = 0; q < 4; ++q) { rp[q] = a0[q]; rp[48 + q] = a1[q]; rp[96 + q] = a2[q]; rp[144 + q] = a3[q]; rp[192 + q] = a4[q]; }
            }
            __syncthreads();
            if (C.tid < 240) { float s = 0.f; for (int j = 0; j < 42; ++j) s += red[j * 240 + C.tid]; const int r = C.tid / 48, n = n0 + C.tid % 48; MOD[r * 12288 + n] = s + P.b_mod[n]; }
            __syncthreads();
        }
    }
    LAS float* scr = (LAS float*)(C.lds + C.wave * 16384);
    bf16_t* WIN = (bf16_t*)(ws + WS_WIN); bf16_t* WUQ = (bf16_t*)(ws + WS_WUQ); bf16_t* WUKV = (bf16_t*)(ws + WS_WUKV); bf16_t* WCAT = (bf16_t*)(ws + WS_WCAT); bf16_t* WOUT = (bf16_t*)(ws + WS_WOUT);
    constexpr int I_IN = 32 * 355, I_UQ = 8 * 96, I_UKV = 8 * 128, I_SQ = 32 * 64;
    constexpr int NITEMS = I_IN + I_UQ + I_UKV + 3 * I_SQ;
    auto p0_item = [&](int it) -> TrItem { int r = it;
        if (r < I_IN) return conv_item(P.w_in, 2048, D_IN, WIN, 2048, 0, r); r -= I_IN;
        if (r < I_UQ) return conv_item(P.w_uq, 512, 3072, WUQ, 512, 0, r); r -= I_UQ;
        if (r < I_UKV) return conv_item(P.w_ukv, 512, 4096, WUKV, 512, 0, r); r -= I_UKV;
        if (r < I_SQ) return conv_item(P.w_o_gla, 2048, 2048, WCAT, 4096, 0, r); r -= I_SQ;
        if (r < I_SQ) return conv_item(P.w_o_mla, 2048, 2048, WCAT, 4096, 2048, r); r -= I_SQ;
        return conv_item(P.w_out, 2048, 2048, WOUT, 2048, 0, r); };
    if (C.gw < NITEMS) {
        f32x4 va[8], vb[8]; TrItem ta = p0_item(C.gw), tb = ta; tr_load(va, ta, C.lane);
        for (int it = C.gw; it < NITEMS; it += 2 * C.ngw) {
            const bool hb = it + C.ngw < NITEMS; if (hb) { tb = p0_item(it + C.ngw); tr_load(vb, tb, C.lane); }
            tr_store(va, ta, scr, C.lane);
            if (!hb) break;
            const bool ha = it + 2 * C.ngw < NITEMS; if (ha) { ta = p0_item(it + 2 * C.ngw); tr_load(va, ta, C.lane); }
            tr_store(vb, tb, scr, C.lane);
        }
    }
    {
        const int gt = blockIdx.x * 512 + C.tid, ngt = gridDim.x * 512;
        u32x4* z = (u32x4*)(WIN + (size_t)D_IN * 2048);
        for (int i = gt; i < (N_INP - D_IN) * 2048 / 8; i += ngt) z[i] = (u32x4){0u, 0u, 0u, 0u};
        float* ROPE = (float*)(ws + WS_ROPE);
        for (int i = gt; i < 4096 * 32; i += ngt) { const int t = i >> 5, part = (i >> 4) & 1, fi = i & 15;
            const float inv = exp2f(-(float)fi * (13.287712379549449f / 16.f)); float sn, cs; sincosf((float)(part ? (t & 63) : (t >> 6)) * inv, &sn, &cs);
            ROPE[(size_t)t * 64 + part * 32 + fi] = cs; ROPE[(size_t)t * 64 + part * 32 + 16 + fi] = sn; }
        bf16_t* WH = (bf16_t*)(ws + WS_WRT); bf16_t* WL = WH + 80 * 2048;
        for (int i = gt; i < 80 * 2048; i += ngt) { const int n = i >> 11, k = i & 2047;
            const float w = (n < 8) ? P.w_rg[k * 8 + n] : (n < 72 ? P.w_re[k * 64 + (n - 8)] : 0.f);
            const bf16_t h = f2bf(w); WH[i] = h; WL[i] = f2bf(w - bf2f(h)); }
    }
}

__device__ __forceinline__ void modulate_row(const float* xr, const float* g, const float* sc, const float* sh, bf16_t* o0, bf16_t* o1, float* rstd_out, int lane) {
    f32x4 v[8]; float s = 0.f;
#pragma unroll
    for (int j = 0; j < 8; ++j) { v[j] = __builtin_nontemporal_load(((const f32x4*)xr) + lane + 64 * j); s += (v[j][0] * v[j][0] + v[j][1] * v[j][1]) + (v[j][2] * v[j][2] + v[j][3] * v[j][3]); }
    const float rstd = 1.f / sqrtf(wave_sum(s) * (1.f / 2048.f) + EPSN);
    if (rstd_out && lane == 0) *rstd_out = rstd;
#pragma unroll
    for (int j = 0; j < 8; ++j) { const int i4 = lane + 64 * j; const f32x4 gg = ((const f32x4*)g)[i4], cc = ((const f32x4*)sc)[i4], hh = ((const f32x4*)sh)[i4];
        const f32x4 y = v[j] * rstd * gg * (cc + 1.f) + hh;
        u32x2 w; w.x = cvt_pk_bf16(y[0], y[1]); w.y = cvt_pk_bf16(y[2], y[3]);
        ((u32x2*)o0)[i4] = w; if (o1) ((u32x2*)o1)[i4] = w; }
}
__device__ __forceinline__ void phase1(const Params& P, const Ctx& C) {
    const float* MOD = (const float*)(P.ws + WS_MOD); bf16_t* H = (bf16_t*)(P.ws + WS_H);
    for (int r0 = C.gw; r0 < TA; r0 += 2 * C.ngw) {
        f32x4 v[2][8]; const int lane = C.lane;
#pragma unroll
        for (int u = 0; u < 2; ++u) { const int r = r0 + u * C.ngw; if (r < TA) { const float* xr = (r < TL) ? P.x + (size_t)r * 2048 : P.ctx + (size_t)(r - TL) * 2048;
#pragma unroll
            for (int j = 0; j < 8; ++j) v[u][j] = __builtin_nontemporal_load(((const f32x4*)xr) + lane + 64 * j); } }
#pragma unroll
        for (int u = 0; u < 2; ++u) { const int r = r0 + u * C.ngw; if (r < TA) { const int b = (r < TL) ? (r >> 12) : 4;
            const float* g = P.norm1_g; const float* sc = MOD + (size_t)b * 12288 + 2048; const float* sh = MOD + (size_t)b * 12288; bf16_t* o0 = H + (size_t)r * 2048;
            float s = 0.f;
#pragma unroll
            for (int j = 0; j < 8; ++j) s += (v[u][j][0] * v[u][j][0] + v[u][j][1] * v[u][j][1]) + (v[u][j][2] * v[u][j][2] + v[u][j][3] * v[u][j][3]);
            const float rstd = 1.f / sqrtf(wave_sum(s) * (1.f / 2048.f) + EPSN);
#pragma unroll
            for (int j = 0; j < 8; ++j) { const int i4 = lane + 64 * j; const f32x4 gg = ((const f32x4*)g)[i4], cc = ((const f32x4*)sc)[i4], hh = ((const f32x4*)sh)[i4];
                const f32x4 y = v[u][j] * rstd * gg * (cc + 1.f) + hh;
                u32x2 w; w.x = cvt_pk_bf16(y[0], y[1]); w.y = cvt_pk_bf16(y[2], y[3]);
                ((u32x2*)o0)[i4] = w; } } }
    }
}
__device__ __forceinline__ void phase3_tok(const Params& P, const Ctx& C) {
    const float* SM = (const float*)(P.ws + WS_SM); bf16_t* CQN = (bf16_t*)(P.ws + WS_CQN); bf16_t* CKVN = (bf16_t*)(P.ws + WS_CKVN); float* SSKR = (float*)(P.ws + WS_SSKR);
    const f32x4 gq0 = *(const f32x4*)(P.q_a_norm_g + 8 * C.lane), gq1 = *(const f32x4*)(P.q_a_norm_g + 8 * C.lane + 4);
    const f32x4 gk0 = *(const f32x4*)(P.kv_a_norm_g + 8 * C.lane), gk1 = *(const f32x4*)(P.kv_a_norm_g + 8 * C.lane + 4);
    const bool hi_only = (gridDim.x == 256);
    if (hi_only && blockIdx.x < 128) return;
    const int gw = hi_only ? C.gw - 1024 : C.gw, ngw = hi_only ? 1024 : C.ngw;
    for (int r0 = gw; r0 < TA; r0 += 4 * ngw) {
        float kv[4]; f32x4 qa[4], qb[4], ka[4], kb[4];
#pragma unroll
        for (int j = 0; j < 4; ++j) { const int r = r0 + j * ngw; if (r < TA) { const float* row = SM + (size_t)r * SMW;
            kv[j] = row[SM_KR + C.lane]; qa[j] = *(const f32x4*)(row + SM_CQ + 8 * C.lane); qb[j] = *(const f32x4*)(row + SM_CQ + 8 * C.lane + 4);
            ka[j] = *(const f32x4*)(row + SM_CKV + 8 * C.lane); kb[j] = *(const f32x4*)(row + SM_CKV + 8 * C.lane + 4); } }
#pragma unroll
        for (int j = 0; j < 4; ++j) { const int r = r0 + j * ngw; if (r < TA) {
            { const float sk = wave_sum(kv[j] * kv[j]); if (C.lane == 0) SSKR[r] = sk; }
            { const f32x4 a = qa[j], b = qb[j];
              float s = (a[0] * a[0] + a[1] * a[1]) + (a[2] * a[2] + a[3] * a[3]) + (b[0] * b[0] + b[1] * b[1]) + (b[2] * b[2] + b[3] * b[3]);
              const float rstd = 1.f / sqrtf(wave_sum(s) * (1.f / 512.f) + EPSN);
              *(u32x4*)(CQN + (size_t)r * 512 + 8 * C.lane) = pack8(a * rstd * gq0, b * rstd * gq1); }
            { const f32x4 a = ka[j], b = kb[j];
              float s = (a[0] * a[0] + a[1] * a[1]) + (a[2] * a[2] + a[3] * a[3]) + (b[0] * b[0] + b[1] * b[1]) + (b[2] * b[2] + b[3] * b[3]);
              const float rstd = 1.f / sqrtf(wave_sum(s) * (1.f / 512.f) + EPSN);
              *(u32x4*)(CKVN + (size_t)r * 512 + 8 * C.lane) = pack8(a * rstd * gk0, b * rstd * gk1); } } }
    }
}
__device__ __forceinline__ void phase5_kprep(const Params& P, const Ctx& C) {
    const float* SM = (const float*)(P.ws + WS_SM); const float* RSTD = (const float*)(P.ws + WS_RSTD); bf16_t* KM = (bf16_t*)(P.ws + WS_KM);
    const float* ROPE = (const float*)(P.ws + WS_ROPE);
    const int lane = C.lane, hs = lane >> 4, fi = lane & 15;
    const float g1r = P.k_norm_g[128 + fi], g2r = P.k_norm_g[144 + fi], g1c = P.k_norm_g[160 + fi], g2c = P.k_norm_g[176 + fi];
    for (int r0 = C.gw; r0 < TA; r0 += 4 * C.ngw) {
        float kx[4][4], rp[4][4], rs[4][4];
#pragma unroll
        for (int j = 0; j < 4; ++j) { const int r = r0 + j * C.ngw; if (r < TA) {
            const float* kr = SM + (size_t)r * SMW + SM_KR;
            kx[j][0] = kr[fi]; kx[j][1] = kr[16 + fi]; kx[j][2] = kr[32 + fi]; kx[j][3] = kr[48 + fi];
            rp[j][0] = 1.f; rp[j][1] = 0.f; rp[j][2] = 1.f; rp[j][3] = 0.f;
            if (r < TL) { const float* rt = ROPE + (size_t)(r & 4095) * 64; rp[j][0] = rt[fi]; rp[j][1] = rt[16 + fi]; rp[j][2] = rt[32 + fi]; rp[j][3] = rt[48 + fi]; }
#pragma unroll
            for (int it = 0; it < 4; ++it) rs[j][it] = RSTD[(size_t)r * 16 + it * 4 + hs]; } }
#pragma unroll
        for (int j = 0; j < 4; ++j) { const int r = r0 + j * C.ngw; if (r < TA) {
            int b, key; if (r < TL) { b = r >> 12; key = r & 4095; } else { const int r2 = r - TL; b = r2 >> 8; key = SEQ + (r2 & 255); }
            const float x1r = kx[j][0] * g1r, x2r = kx[j][1] * g2r, x1c = kx[j][2] * g1c, x2c = kx[j][3] * g2c;
            const float csr = rp[j][0], snr = rp[j][1], csc = rp[j][2], snc = rp[j][3];
            const float y1r = x1r * csr - x2r * snr, y2r = x1r * snr + x2r * csr, y1c = x1c * csc - x2c * snc, y2c = x1c * snc + x2c * csc;
#pragma unroll
            for (int it = 0; it < 4; ++it) { bf16_t* o = KM + ((size_t)(b * 16 + it * 4 + hs) * NKEY + key) * 192;
                o[128 + fi] = f2bf(y1r * rs[j][it]); o[144 + fi] = f2bf(y2r * rs[j][it]); o[160 + fi] = f2bf(y1c * rs[j][it]); o[176 + fi] = f2bf(y2c * rs[j][it]); } } }
    }
}
__device__ __forceinline__ void phase5_readout(const Params& P, const Ctx& C) {
    const bf16_t* OF = (const bf16_t*)(P.ws + WS_OF); const bf16_t* OB = (const bf16_t*)(P.ws + WS_OB); const bf16_t* R = (const bf16_t*)(P.ws + WS_R); bf16_t* YC = (bf16_t*)(P.ws + WS_YCAT);
    const f32x4 g0 = *(const f32x4*)(P.gla_norm_g + 8 * C.lane), g1 = *(const f32x4*)(P.gla_norm_g + 8 * C.lane + 4);
    u32x4 a[2], b[2], rr[2], na[2], nb[2], nr[2];
#define RO_FETCH(A_, B_, R_, it0_) do { _Pragma("unroll") for (int u = 0; u < 2; ++u) { const int it = (it0_) + u, t = it >> 2, h = it & 3; const size_t off = (size_t)t * 2048 + h * 512 + 8 * C.lane; \
        A_[u] = *(const u32x4*)(OF + off); B_[u] = *(const u32x4*)(OB + off); R_[u] = *(const u32x4*)(R + off); } } while (0)
    if (C.gw * 2 < TL * 4) RO_FETCH(na, nb, nr, C.gw * 2);
    for (int it0 = C.gw * 2; it0 < TL * 4; it0 += C.ngw * 2) {
#pragma unroll
        for (int u = 0; u < 2; ++u) { a[u] = na[u]; b[u] = nb[u]; rr[u] = nr[u]; }
        if (it0 + C.ngw * 2 < TL * 4) RO_FETCH(na, nb, nr, it0 + C.ngw * 2);
#pragma unroll
        for (int u = 0; u < 2; ++u) { const int it = it0 + u, t = it >> 2, h = it & 3;
            float o[8], rv[8]; float s = 0.f;
#pragma unroll
            for (int j = 0; j < 4; ++j) { o[2 * j] = bf_lo(a[u][j]) + bf_lo(b[u][j]); o[2 * j + 1] = bf_hi(a[u][j]) + bf_hi(b[u][j]); rv[2 * j] = bf_lo(rr[u][j]); rv[2 * j + 1] = bf_hi(rr[u][j]); }
#pragma unroll
            for (int j = 0; j < 8; ++j) s += o[j] * o[j];
            const float rstd = 1.f / sqrtf(wave_sum(s) * (1.f / 512.f) + EPSN);
            f32x4 y0, y1;
#pragma unroll
            for (int j = 0; j < 4; ++j) { y0[j] = o[j] * rstd * g0[j] * siluf_(rv[j]); y1[j] = o[4 + j] * rstd * g1[j] * siluf_(rv[4 + j]); }
#ifdef DBG_ZERO_GLA
            y0 = (f32x4){0.f, 0.f, 0.f, 0.f}; y1 = y0;
#endif
            *(u32x4*)(YC + (size_t)t * 4096 + h * 512 + 8 * C.lane) = pack8(y0, y1); }
    }
#undef RO_FETCH
}
__device__ __forceinline__ float log_sigmoidf_(float z) { return -(fmaxf(-z, 0.f) + log1pf(expf(-fabsf(z)))); }
__device__ __forceinline__ int gla_row0(int b, int c) { return (c < 4) ? (TL + b * 256 + c * 64) : (b * 4096 + (c - 4) * 64); }
constexpr int QDS_LD = 264, KET_LD = 72;

__device__ __forceinline__ float lsig16_(float z) { return (fminf(z, 0.f) - __logf(1.f + __expf(-fabsf(z)))) * 0.0625f; }
__device__ __forceinline__ void phase3_gla(const Params& P, const Ctx& C) {
    const unsigned char* ws = P.ws;
    const float* SM = (const float*)(ws + WS_SM); const bf16_t* QK = (const bf16_t*)(ws + WS_QK);
    bf16_t* QDg = (bf16_t*)(ws + WS_H); bf16_t* KETg = (bf16_t*)(ws + WS_KET); bf16_t* ATTg = (bf16_t*)(ws + WS_ATT); float* DEg = (float*)(ws + WS_DE);
    LAS float* AFs = (LAS float*)C.lds;
    LAS bf16_t* QDs = (LAS bf16_t*)(C.lds + 4096);
    LAS bf16_t* KIs = (LAS bf16_t*)(C.lds + 4096 + 64 * QDS_LD * 2);
    LAS float* Gs = (LAS float*)(C.lds + 4096 + 2 * 64 * QDS_LD * 2);
    const int tid = C.tid, half = tid >> 8, d = tid & 255;
    u32x4 nq[4], nk[4]; float naf[2]; f32x2 nw2[8]; float nbias = 0.f;
#define GLA3_FETCH(u_) do { const int dir_ = (u_) & 1, u2_ = (u_) >> 1, bh_ = u2_ / NCH, c_ = u2_ % NCH, row0_ = gla_row0(bh_ >> 2, c_), h_ = bh_ & 3, hd_ = h_ * 256 + d; \
        _Pragma("unroll") for (int k_ = 0; k_ < 4; ++k_) { const int idx_ = tid + 512 * k_, i_ = idx_ >> 5, c8_ = (idx_ & 31) * 8; \
            nq[k_] = *(const u32x4*)(QK + (size_t)(row0_ + i_) * 2048 + h_ * 256 + c8_); nk[k_] = *(const u32x4*)(QK + (size_t)(row0_ + i_) * 2048 + 1024 + h_ * 256 + c8_); } \
        _Pragma("unroll") for (int k_ = 0; k_ < 2; ++k_) { const int i_ = tid + 512 * k_; naf[k_] = SM[(size_t)(row0_ + (i_ >> 4)) * SMW + dir_ * 16 + (i_ & 15)]; } \
        const float* wd_ = dir_ ? P.w_decay_b : P.w_decay_f; \
        _Pragma("unroll") for (int j_ = 0; j_ < 8; ++j_) { nw2[j_].x = wd_[(2 * j_) * 1024 + hd_]; nw2[j_].y = wd_[(2 * j_ + 1) * 1024 + hd_]; } \
        nbias = (dir_ ? P.b_decay_b : P.b_decay_f)[hd_]; } while (0)
    if ((int)blockIdx.x < 32 * NCH) GLA3_FETCH((int)blockIdx.x);
    for (int unit = blockIdx.x; unit < 32 * NCH; unit += gridDim.x) {
        const int dir = unit & 1, u2 = unit >> 1, bh = u2 / NCH, c = u2 % NCH, b = bh >> 2, h = bh & 3, row0 = gla_row0(b, c);
        const size_t cidx = (size_t)(dir * 16 + bh) * NCH + c;
        __syncthreads();
#pragma unroll
        for (int k = 0; k < 2; ++k) AFs[tid + 512 * k] = naf[k];
#pragma unroll
        for (int k = 0; k < 4; ++k) { const int idx = tid + 512 * k, i = idx >> 5, c8 = (idx & 31) * 8;
            *(LAS u32x4*)(QDs + i * QDS_LD + c8) = nq[k]; *(LAS u32x4*)(KIs + i * QDS_LD + c8) = nk[k]; }
        f32x2 w2[8];
#pragma unroll
        for (int j = 0; j < 8; ++j) w2[j] = nw2[j];
        const float bias = nbias;
        if (unit + (int)gridDim.x < 32 * NCH) GLA3_FETCH(unit + (int)gridDim.x);
        __syncthreads();
        float rsum = 0.f;
#pragma unroll 4
        for (int ii = 0; ii < 32; ++ii) { const int i = half * 32 + ii;
            const LAS f32x4* ar = (const LAS f32x4*)(AFs + i * 16); f32x2 z2 = {bias, 0.f};
#pragma unroll
            for (int j4 = 0; j4 < 4; ++j4) { const f32x4 a = ar[j4]; z2 += (f32x2){a[0], a[1]} * w2[2 * j4]; z2 += (f32x2){a[2], a[3]} * w2[2 * j4 + 1]; }
            const float g = lsig16_(z2.x + z2.y); Gs[i * 256 + d] = g; rsum += g; }
        LAS float* hx = (LAS float*)((LAS unsigned char*)QDs + (d & 127) * (QDS_LD * 2) + 512) + (d >> 7) * 2;
        hx[half] = rsum;
        __syncthreads();
        const float other = hx[half ^ 1];
        const float bend = rsum + other, eb = __expf(bend);
        const float off = dir ? (half ? 0.f : other) : (half ? other : 0.f);
        if (half == 0) DEg[cidx * 256 + d] = eb;
        float run = 0.f;
        for (int g8 = 0; g8 < 4; ++g8) {
            float ke[8];
#pragma unroll
            for (int s = 0; s < 8; ++s) {
                const int i = half * 32 + g8 * 8 + s;
                const float g = Gs[i * 256 + d];
                float bc;
                if (dir) { bc = (rsum - run) + off; run += g; } else { run += g; bc = run + off; }
                const float qv = bf2f(QDs[i * QDS_LD + d]) * 0.0625f, kv = bf2f(KIs[i * QDS_LD + d]);
                const float ki = kv * __expf(-bc);
                ke[s] = ki * eb;
                QDs[i * QDS_LD + d] = f2bf(qv * __expf(bc)); KIs[i * QDS_LD + d] = f2bf(ki);
            }
            u32x4 w0;
            w0.x = cvt_pk_bf16(ke[0], ke[1]); w0.y = cvt_pk_bf16(ke[2], ke[3]); w0.z = cvt_pk_bf16(ke[4], ke[5]); w0.w = cvt_pk_bf16(ke[6], ke[7]);
            *(u32x4*)(KETg + cidx * 16384 + ((size_t)(((d >> 5) * 4 + half * 2 + (g8 >> 1)) * 64 + (d & 31) + 32 * (g8 & 1))) * 8) = w0;
        }
        __syncthreads();
#pragma unroll
        for (int k = 0; k < 4; ++k) { const int idx = tid + 512 * k, i = idx >> 5, c8 = (idx & 31) * 8;
            *(u32x4*)(QDg + ((size_t)dir * TA + row0 + i) * 1024 + h * 256 + c8) = *(const LAS u32x4*)(QDs + i * QDS_LD + c8); }
        {
            const int n16 = C.lane & 15, kq = C.lane >> 4, ib = C.wave & 3, jb0 = 2 * (C.wave >> 2);
            f32x4 a0 = {0, 0, 0, 0}, a1 = {0, 0, 0, 0};
            const LAS bf16_t* qa = QDs + (16 * ib + n16) * QDS_LD + 8 * kq;
            const LAS bf16_t* kb0 = KIs + (16 * jb0 + n16) * QDS_LD + 8 * kq;
            const LAS bf16_t* kb1 = kb0 + 16 * QDS_LD;
#pragma unroll
            for (int s = 0; s < 8; ++s) { const bf16x8 av = *(const LAS bf16x8*)(qa + 32 * s);
                a0 = __builtin_amdgcn_mfma_f32_16x16x32_bf16(av, *(const LAS bf16x8*)(kb0 + 32 * s), a0, 0, 0, 0);
                a1 = __builtin_amdgcn_mfma_f32_16x16x32_bf16(av, *(const LAS bf16x8*)(kb1 + 32 * s), a1, 0, 0, 0); }
#pragma unroll
            for (int r = 0; r < 4; ++r) { const int i = 16 * ib + 4 * kq + r, j0 = 16 * jb0 + n16, j1 = j0 + 16;
                const bool k0 = dir ? (j0 >= i) : (j0 <= i), k1 = dir ? (j1 >= i) : (j1 <= i);
                ATTg[(cidx * 64 + i) * 64 + j0] = f2bf(k0 ? a0[r] : 0.f); ATTg[(cidx * 64 + i) * 64 + j1] = f2bf(k1 ? a1[r] : 0.f); }
        }
    }
}

#undef GLA3_FETCH
__device__ __forceinline__ void phase4_scan(const Params& P, const Ctx& C) {
    const unsigned char* ws = P.ws;
    const bf16_t* QDg = (const bf16_t*)(ws + WS_H); const bf16_t* KETg = (const bf16_t*)(ws + WS_KET); const bf16_t* ATTg = (const bf16_t*)(ws + WS_ATT);
    const float* DEg = (const float*)(ws + WS_DE); const bf16_t* Vg = (const bf16_t*)(ws + WS_V);
    constexpr int BO_A = 0, BO_B = 53248, BO_QD = 0, BO_ATT = 33792, BO_VT = 43008, BO_DE = 52224;
    LAS bf16_t* STs = (LAS bf16_t*)(C.lds + 106496);
    const int tid = C.tid, lane = C.lane, w = C.wave;
    for (int unit = blockIdx.x; unit < 256; unit += gridDim.x) {
        const int seqid = (unit & 7) * 4 + (unit >> 6), slice = (unit >> 3) & 7, b = seqid >> 3, h = (seqid >> 1) & 3, dir = seqid & 1, bh = b * 4 + h;
        bf16_t* Og = (bf16_t*)(P.ws + (dir ? WS_OB : WS_OF));
        f32x16 S0 = {}, S1 = {};
        u32x4 rqA[4], rkA[4], raA, rvA, rqB[4], rkB[4], raB, rvB; f32x4 rdA = {0, 0, 0, 0}, rdB = {0, 0, 0, 0};
#define CHUNK_OF(step) (dir ? ((step) < 4 ? 3 - (step) : 71 - (step)) : (step))
#define GLA_LOAD(X, step) do { const int c_ = CHUNK_OF(step), row0_ = gla_row0(b, c_); const size_t cidx_ = ((size_t)(dir * 16 + bh) * NCH + c_); \
        _Pragma("unroll") for (int k_ = 0; k_ < 4; ++k_) { const int idx_ = tid + 512 * k_; \
            rq##X[k_] = *(const u32x4*)(QDg + ((size_t)dir * TA + row0_ + (idx_ >> 5)) * 1024 + h * 256 + (idx_ & 31) * 8); } \
        ra##X = *(const u32x4*)(ATTg + cidx_ * 4096 + tid * 8); \
        rv##X = *(const u32x4*)(Vg + (size_t)(row0_ + (tid >> 3)) * 2048 + h * 512 + slice * 64 + (tid & 7) * 8); \
        if (tid < 64) rd##X = *(const f32x4*)(DEg + cidx_ * 256 + tid * 4); } while (0)
#define GLA_LOADK(X, step) do { const int c_ = CHUNK_OF(step); const size_t cidx_ = ((size_t)(dir * 16 + bh) * NCH + c_); \
        _Pragma("unroll") for (int s_ = 0; s_ < 4; ++s_) rk##X[s_] = *(const u32x4*)(KETg + cidx_ * 16384 + (size_t)((w * 4 + s_) * 64 + lane) * 8); } while (0)
#define GLA_STAGE(X) do { LAS bf16_t* QDs_ = (LAS bf16_t*)(C.lds + BO_##X + BO_QD); LAS bf16_t* ATTs_ = (LAS bf16_t*)(C.lds + BO_##X + BO_ATT); LAS bf16_t* VTs_ = (LAS bf16_t*)(C.lds + BO_##X + BO_VT); \
            _Pragma("unroll") for (int k = 0; k < 4; ++k) { const int idx = tid + 512 * k; \
                *(LAS u32x4*)(QDs_ + (idx >> 5) * QDS_LD + (idx & 31) * 8) = rq##X[k]; } \
            *(LAS u32x4*)(ATTs_ + (tid >> 3) * KET_LD + (tid & 7) * 8) = ra##X; \
            { const int j = tid >> 3, e8 = (tid & 7) * 8; \
              const int js = j ^ e8;        \
              _Pragma("unroll") for (int q = 0; q < 4; ++q) { VTs_[(e8 + 2 * q) * KET_LD + js] = (bf16_t)(rv##X[q] & 0xffffu); VTs_[(e8 + 2 * q + 1) * KET_LD + js] = (bf16_t)(rv##X[q] >> 16); } } \
            if (tid < 64) *(LAS f32x4*)((LAS float*)(C.lds + BO_##X + BO_DE) + tid * 4) = rd##X; } while (0)
#define GLA_STWRITE() do {     \
                const int e = lane & 31, hh = lane >> 5; \
                _Pragma("unroll") for (int g = 0; g < 4; ++g) { u32x2 p0, p1; \
                    p0.x = cvt_pk_bf16(S0[4 * g], S0[4 * g + 1]); p0.y = cvt_pk_bf16(S0[4 * g + 2], S0[4 * g + 3]); \
                    p1.x = cvt_pk_bf16(S1[4 * g], S1[4 * g + 1]); p1.y = cvt_pk_bf16(S1[4 * g + 2], S1[4 * g + 3]); \
                    *(LAS u32x2*)(STs + e * QDS_LD + 32 * w + 8 * g + 4 * hh) = p0; \
                    *(LAS u32x2*)(STs + (32 + e) * QDS_LD + 32 * w + 8 * g + 4 * hh) = p1; } } while (0)
#define GLA_STEP(X, Y, step) do { \
            const int c = CHUNK_OF(step); \
            const LAS bf16_t* QDs = (const LAS bf16_t*)(C.lds + BO_##X + BO_QD); const LAS bf16_t* ATTs = (const LAS bf16_t*)(C.lds + BO_##X + BO_ATT); \
            const LAS bf16_t* VTs = (const LAS bf16_t*)(C.lds + BO_##X + BO_VT); const LAS float* DEs = (const LAS float*)(C.lds + BO_##X + BO_DE); \
            __syncthreads();                                     \
            if ((step) + 1 < NCH) GLA_STAGE(Y);                  \
            if ((step) + 3 < NCH) GLA_LOAD(Y, (step) + 3); \
            if (c >= 4) {     \
                const int n16 = lane & 15, kq = lane >> 4, i0 = 16 * (w & 3), e0 = 32 * (w >> 2); \
                f32x4 o0 = {0, 0, 0, 0}, o1 = {0, 0, 0, 0}; \
                _Pragma("unroll") for (int s = 0; s < 2; ++s) { const bf16x8 bi = *(const LAS bf16x8*)(ATTs + (i0 + n16) * KET_LD + 32 * s + 8 * kq); \
                    o0 = __builtin_amdgcn_mfma_f32_16x16x32_bf16(*(const LAS bf16x8*)(VTs + (e0 + n16) * KET_LD + ((32 * s + 8 * kq) ^ (((e0 + n16) >> 3) << 3))), bi, o0, 0, 0, 0); \
                    o1 = __builtin_amdgcn_mfma_f32_16x16x32_bf16(*(const LAS bf16x8*)(VTs + (e0 + 16 + n16) * KET_LD + ((32 * s + 8 * kq) ^ (((e0 + 16 + n16) >> 3) << 3))), bi, o1, 0, 0, 0); } \
                _Pragma("unroll") for (int s = 0; s < 8; ++s) { const bf16x8 bi = *(const LAS bf16x8*)(QDs + (i0 + n16) * QDS_LD + 32 * s + 8 * kq); \
                    o0 = __builtin_amdgcn_mfma_f32_16x16x32_bf16(*(const LAS bf16x8*)(STs + (e0 + n16) * QDS_LD + 32 * s + 8 * kq), bi, o0, 0, 0, 0); \
                    o1 = __builtin_amdgcn_mfma_f32_16x16x32_bf16(*(const LAS bf16x8*)(STs + (e0 + 16 + n16) * QDS_LD + 32 * s + 8 * kq), bi, o1, 0, 0, 0); } \
                  \
                bf16_t* op = Og + (size_t)(gla_row0(b, c) + i0 + n16) * 2048 + h * 512 + slice * 64 + e0 + 4 * kq; \
                u32x2 p0, p1; p0.x = cvt_pk_bf16(o0[0], o0[1]); p0.y = cvt_pk_bf16(o0[2], o0[3]); p1.x = cvt_pk_bf16(o1[0], o1[1]); p1.y = cvt_pk_bf16(o1[2], o1[3]); \
                *(u32x2*)op = p0; *(u32x2*)(op + 16) = p1; \
            } \
            {     \
                const int l31 = lane & 31, hh = lane >> 5; \
                _Pragma("unroll") for (int r = 0; r < 16; ++r) { const float de = DEs[32 * w + (r & 3) + 8 * (r >> 2) + 4 * hh]; S0[r] *= de; S1[r] *= de; } \
                _Pragma("unroll") for (int s = 0; s < 4; ++s) { const bf16x8 ak = *reinterpret_cast<const bf16x8*>(&rk##X[s]); \
                    S0 = __builtin_amdgcn_mfma_f32_32x32x16_bf16(ak, *(const LAS bf16x8*)(VTs + l31 * KET_LD + ((16 * s + 8 * hh) ^ ((l31 >> 3) << 3))), S0, 0, 0, 0); \
                    S1 = __builtin_amdgcn_mfma_f32_32x32x16_bf16(ak, *(const LAS bf16x8*)(VTs + (32 + l31) * KET_LD + ((16 * s + 8 * hh) ^ (((32 + l31) >> 3) << 3))), S1, 0, 0, 0); } \
                if ((step) + 2 < NCH) GLA_LOADK(X, (step) + 2);        \
            } \
            __syncthreads();                                     \
            GLA_STWRITE(); \
        } while (0)
        GLA_LOAD(A, 0); GLA_LOADK(A, 0); GLA_LOAD(B, 1); GLA_LOADK(B, 1);
        __syncthreads();
        GLA_STAGE(A); GLA_STWRITE(); GLA_LOAD(A, 2);
        for (int step = 0; step < NCH; step += 2) { GLA_STEP(A, B, step); GLA_STEP(B, A, step + 1); }
#undef GLA_STAGE
#undef GLA_STWRITE
#undef GLA_STEP
#undef GLA_LOAD
#undef GLA_LOADK
#undef CHUNK_OF
    }
}
namespace attn {
constexpr int NW = 8, QBLK = 32, KVBLK = 64;
constexpr float SCALE = 0.07216878364870322f;
constexpr float THR = 8.f;
constexpr int SHM_V = KVBLK * 128 * 2, SHM_K = 32 * 1056;
constexpr int OFF_V = 0, OFF_K = 3 * SHM_V, OFF_WS = OFF_K + 2 * SHM_K, SHM_ATTN = OFF_WS + NW * 64 * 4;
#define KSWZ(row, colB) (((row) >> 1) * 1056 + ((row) & 1) * 400 + (colB))
#define SBAR() __builtin_amdgcn_sched_barrier(0)
__device__ __forceinline__ int crow(int r, int hi) { return (r & 3) + 8 * (r >> 2) + 4 * hi; }

__device__ __forceinline__ void partialSM(f32x16& p0, f32x16& p1, float& m_reg, float& mn, float& alpha) {
  constexpr float Cc = SCALE * 1.4426950408889634f;
  float pmax = p0[0];
#pragma unroll
  for (int r = 1; r < 16; ++r) pmax = fmaxf(pmax, p0[r]);
#pragma unroll
  for (int r = 0; r < 16; ++r) pmax = fmaxf(pmax, p1[r]);
  { auto rr = __builtin_amdgcn_permlane32_swap(__float_as_uint(pmax), __float_as_uint(pmax), false, false);
    pmax = fmaxf(__uint_as_float(rr[0]), __uint_as_float(rr[1])); }
  if (__builtin_expect(__all(pmax - m_reg <= THR / SCALE), 1)) { mn = m_reg; alpha = 1.f; }
  else { mn = fmaxf(m_reg, pmax); alpha = __builtin_amdgcn_exp2f((m_reg - mn) * Cc); m_reg = mn; }
  const float mnC = -mn * Cc; const f32x2 c2 = {Cc, Cc}, m2 = {mnC, mnC};
#pragma unroll
  for (int r = 0; r < 8; ++r) { const f32x2 v = (f32x2){p0[2 * r], p0[2 * r + 1]} * c2 + m2;
    p0[2 * r] = __builtin_amdgcn_exp2f(v.x); p0[2 * r + 1] = __builtin_amdgcn_exp2f(v.y); }
#pragma unroll
  for (int r = 0; r < 8; ++r) { const f32x2 v = (f32x2){p1[2 * r], p1[2 * r + 1]} * c2 + m2; p1[2 * r] = v.x; p1[2 * r + 1] = v.y; }
}
__device__ __forceinline__ void finishSM(f32x16& p0, f32x16& p1, float alpha, float& l_reg, bf16x8& pa0, bf16x8& pa1, bf16x8& pa2, bf16x8& pa3) {
#pragma unroll
  for (int r = 0; r < 16; ++r) p1[r] = __builtin_amdgcn_exp2f(p1[r]);
  f32x2 ps2 = {0.f, 0.f};
#pragma unroll
  for (int r = 0; r < 8; ++r) ps2 += (f32x2){p0[2 * r], p0[2 * r + 1]};
#pragma unroll
  for (int r = 0; r < 8; ++r) ps2 += (f32x2){p1[2 * r], p1[2 * r + 1]};
  float ps = ps2.x + ps2.y;
  { auto rr = __builtin_amdgcn_permlane32_swap(__float_as_uint(ps), __float_as_uint(ps), false, false);
    ps = __uint_as_float(rr[0]) + __uint_as_float(rr[1]); }
  l_reg = l_reg * alpha + ps;
#define PK4(Pv, BASE, OUT) do { unsigned a0 = cvt_pk_bf16(Pv[BASE + 0], Pv[BASE + 1]), a1 = cvt_pk_bf16(Pv[BASE + 2], Pv[BASE + 3]);   \
    unsigned b0 = cvt_pk_bf16(Pv[BASE + 4], Pv[BASE + 5]), b1 = cvt_pk_bf16(Pv[BASE + 6], Pv[BASE + 7]);                              \
    auto r0 = __builtin_amdgcn_permlane32_swap(a0, b0, false, false); auto r1 = __builtin_amdgcn_permlane32_swap(a1, b1, false, false); \
    u32x4 w_ = {r0[0], r1[0], r0[1], r1[1]}; OUT = *reinterpret_cast<bf16x8*>(&w_); } while (0)
  PK4(p0, 0, pa0); PK4(p0, 8, pa1); PK4(p1, 0, pa2); PK4(p1, 8, pa3);
#undef PK4
}
#ifndef QK_AHEAD
#define QK_AHEAD 4
#endif
__device__ __forceinline__ void qkt(f32x16& p0, f32x16& p1, const LAS unsigned char* Ks, const bf16x8* qr, int r32, int hi) {
  p0 = f32x16{}; p1 = f32x16{};
#pragma unroll
  for (int d0 = 0; d0 < 12; ++d0) p0 = __builtin_amdgcn_mfma_f32_32x32x16_bf16(*(const LAS bf16x8*)(Ks + KSWZ(r32, (d0 * 16 + hi * 8) * 2)), qr[d0], p0, 0, 0, 0);
  __builtin_amdgcn_sched_group_barrier(0x100, QK_AHEAD, 0);
#pragma unroll
  for (int d0 = 0; d0 < 12 - QK_AHEAD; ++d0) { __builtin_amdgcn_sched_group_barrier(0x8, 1, 0); __builtin_amdgcn_sched_group_barrier(0x100, 1, 0); }
  __builtin_amdgcn_sched_group_barrier(0x8, QK_AHEAD, 0);
#pragma unroll
  for (int d0 = 0; d0 < 12; ++d0) p1 = __builtin_amdgcn_mfma_f32_32x32x16_bf16(*(const LAS bf16x8*)(Ks + KSWZ(32 + r32, (d0 * 16 + hi * 8) * 2)), qr[d0], p1, 0, 0, 0);
  __builtin_amdgcn_sched_group_barrier(0x100, QK_AHEAD, 0);
#pragma unroll
  for (int d0 = 0; d0 < 12 - QK_AHEAD; ++d0) { __builtin_amdgcn_sched_group_barrier(0x8, 1, 0); __builtin_amdgcn_sched_group_barrier(0x100, 1, 0); }
  __builtin_amdgcn_sched_group_barrier(0x8, QK_AHEAD, 0);
}
__device__ __forceinline__ int v_st(int k, int c) { const int kk = (k & ~0xC) | ((k & 4) << 1) | ((k & 8) >> 1); return ((kk >> 3) * 4 + (c >> 5)) * 512 + ((kk & 7) * 32 + (c & 31)) * 2; }
__device__ __forceinline__ int v_rd_base(int lane) { return ((lane & 3) << 3) | (((lane >> 2) & 3) << 6) | (((lane >> 4) & 1) << 5) | (((lane >> 5) & 1) << 8); }
constexpr int v_rd_off(int d0, int ks, int half) { return d0 * 512 + ks * 4096 + half * 2048; }
template <int OFF> __device__ __forceinline__ s16x4 tr_read(int vb) {
  s16x4 r; asm volatile("ds_read_b64_tr_b16 %0, %1 offset:%2" : "=&v"(r) : "v"(vb), "i"(OFF) : "memory"); return r;
}
template <int D0> __device__ __forceinline__ void pv_one(f32x16& od, int vb, bf16x8 pa0, bf16x8 pa1, bf16x8 pa2, bf16x8 pa3) {
  const s16x4 l0 = tr_read<v_rd_off(D0, 0, 0)>(vb), h0 = tr_read<v_rd_off(D0, 0, 1)>(vb), l1 = tr_read<v_rd_off(D0, 1, 0)>(vb), h1 = tr_read<v_rd_off(D0, 1, 1)>(vb);
  const s16x4 l2 = tr_read<v_rd_off(D0, 2, 0)>(vb), h2 = tr_read<v_rd_off(D0, 2, 1)>(vb), l3 = tr_read<v_rd_off(D0, 3, 0)>(vb), h3 = tr_read<v_rd_off(D0, 3, 1)>(vb);
  asm volatile("s_waitcnt lgkmcnt(0)" ::: "memory"); SBAR();
#define PKV(L, H) (bf16x8){L[0], L[1], L[2], L[3], H[0], H[1], H[2], H[3]}
  od = __builtin_amdgcn_mfma_f32_32x32x16_bf16(pa0, PKV(l0, h0), od, 0, 0, 0);
  od = __builtin_amdgcn_mfma_f32_32x32x16_bf16(pa1, PKV(l1, h1), od, 0, 0, 0);
  od = __builtin_amdgcn_mfma_f32_32x32x16_bf16(pa2, PKV(l2, h2), od, 0, 0, 0);
  od = __builtin_amdgcn_mfma_f32_32x32x16_bf16(pa3, PKV(l3, h3), od, 0, 0, 0);
#undef PKV
}
__device__ __forceinline__ void pv_d0(f32x16* o, int vb, bf16x8 pa0, bf16x8 pa1, bf16x8 pa2, bf16x8 pa3) {
  pv_one<0>(o[0], vb, pa0, pa1, pa2, pa3); pv_one<1>(o[1], vb, pa0, pa1, pa2, pa3); pv_one<2>(o[2], vb, pa0, pa1, pa2, pa3); pv_one<3>(o[3], vb, pa0, pa1, pa2, pa3);
}

template <int APROBE> __device__ __forceinline__ void attn_unit(const bf16_t* __restrict__ Qb, const bf16_t* __restrict__ Kh, const bf16_t* __restrict__ Vh, bf16_t* __restrict__ Ob,
                                          int tpos0, const float* __restrict__ qng, const float* __restrict__ rope, LAS unsigned char* lds) {
  int tid_ = threadIdx.x; asm volatile("" : "+v"(tid_));
  const int tid = tid_, wid = tid >> 6, lane = tid & 63, r32 = lane & 31, hi = lane >> 5;
  LAS unsigned char* V_lds = lds + OFF_V; LAS unsigned char* K_lds = lds + OFF_K;
  LAS float* wsf = (LAS float*)(lds + OFF_WS) + wid * 64; LAS float* li_l = wsf; LAS float* al_l = wsf + 32;
  float m_reg = -1e30f, l_reg = 0.f; f32x16 o[4]; bf16x8 qr[12];
  const int vb0 = (int)(uintptr_t)V_lds + v_rd_base(lane);
  const int wu = __builtin_amdgcn_readfirstlane(wid);
#define DMA_TILE(k0, kb, vb_) do { int l_ = lane; asm volatile("" : "+v"(l_)); \
    const char* kt_ = (const char*)Kh + (size_t)(k0) * 384 + (size_t)wu * 768; const char* vt_ = (const char*)Vh + (size_t)(k0) * 256; \
    const int rip_ = l_ >= 25 ? 1 : 0, cc_ = l_ - 25 * rip_; const unsigned ka_ = (unsigned)(rip_ * 384 + (cc_ < 24 ? cc_ : 23) * 16 - (l_ >= 50 ? 0 : 0)); \
    const unsigned kao_ = l_ >= 50 ? (unsigned)(384 + 23 * 16) : ka_; \
    _Pragma("unroll") for (int i_ = 0; i_ < 4; ++i_) \
        __builtin_amdgcn_global_load_lds((const unsigned*)(kt_ + i_ * 6144 + kao_), (LAS unsigned*)(K_lds + (kb) * SHM_K + (wu + 8 * i_) * 1056), 16, 0, 0); \
    _Pragma("unroll") for (int i_ = 0; i_ < 2; ++i_) { \
        const int kk_ = (wu << 3) | ((l_ & 31) >> 2), c_ = (((i_ << 1) | (l_ >> 5)) << 5) | ((l_ & 3) << 3), k_ = (kk_ & ~0xC) | ((kk_ & 4) << 1) | ((kk_ & 8) >> 1); \
        __builtin_amdgcn_global_load_lds((const unsigned*)(vt_ + (unsigned)(k_ * 256 + c_ * 2)), (LAS unsigned*)(V_lds + (vb_) * SHM_V + (2 * wu + i_) * 1024), 16, 0, 0); } } while (0)
#define DMA_WAIT() asm volatile("s_waitcnt vmcnt(0)" ::: "memory")
  DMA_TILE(0, 0, 0);
  {
    const bf16_t* Qw = Qb + (size_t)(wid * QBLK + r32) * 3072 + hi * 8;
    float ss = 0.f;
#pragma unroll
    for (int d0 = 0; d0 < 12; ++d0) { const u32x4 rw = *(const u32x4*)(Qw + d0 * 16);
#pragma unroll
      for (int j = 0; j < 4; ++j) { const float a = bf_lo(rw[j]), b = bf_hi(rw[j]); ss += a * a + b * b; } }
    { auto rr_ = __builtin_amdgcn_permlane32_swap(__float_as_uint(ss), __float_as_uint(ss), false, false); ss = __uint_as_float(rr_[0]) + __uint_as_float(rr_[1]); }
    const float rstd = 1.f / sqrtf(ss * (1.f / 192.f) + EPSN);
    asm volatile("" ::: "memory");
#pragma unroll
    for (int d0 = 0; d0 < 8; ++d0) { const u32x4 rw = *(const u32x4*)(Qw + d0 * 16);
      const f32x4 g0 = *(const f32x4*)(qng + d0 * 16 + hi * 8), g1 = *(const f32x4*)(qng + d0 * 16 + hi * 8 + 4);
      u32x4 w; w.x = cvt_pk_bf16(bf_lo(rw[0]) * rstd * g0[0], bf_hi(rw[0]) * rstd * g0[1]); w.y = cvt_pk_bf16(bf_lo(rw[1]) * rstd * g0[2], bf_hi(rw[1]) * rstd * g0[3]);
      w.z = cvt_pk_bf16(bf_lo(rw[2]) * rstd * g1[0], bf_hi(rw[2]) * rstd * g1[1]); w.w = cvt_pk_bf16(bf_lo(rw[3]) * rstd * g1[2], bf_hi(rw[3]) * rstd * g1[3]);
      qr[d0] = *reinterpret_cast<bf16x8*>(&w); }
    const int tpos = tpos0 + wid * QBLK + r32;
#pragma unroll
    for (int part = 0; part < 2; ++part) {
      const u32x4 ra = *(const u32x4*)(Qw + (8 + 2 * part) * 16), rb = *(const u32x4*)(Qw + (9 + 2 * part) * 16);
      const float* rt = rope + (size_t)tpos * 64 + part * 32 + 8 * hi;
      const f32x4 c0 = *(const f32x4*)rt, c1 = *(const f32x4*)(rt + 4), s0 = *(const f32x4*)(rt + 16), s1 = *(const f32x4*)(rt + 20);
      const f32x4 ga0 = *(const f32x4*)(qng + 128 + 32 * part + 8 * hi), ga1 = *(const f32x4*)(qng + 132 + 32 * part + 8 * hi), gb0 = *(const f32x4*)(qng + 144 + 32 * part + 8 * hi), gb1 = *(const f32x4*)(qng + 148 + 32 * part + 8 * hi);
      float y1[8], y2[8];
#pragma unroll
      for (int j = 0; j < 8; ++j) {
        const float x1 = ((j & 1) ? bf_hi(ra[j >> 1]) : bf_lo(ra[j >> 1])) * rstd * (j < 4 ? ga0[j & 3] : ga1[j & 3]);
        const float x2 = ((j & 1) ? bf_hi(rb[j >> 1]) : bf_lo(rb[j >> 1])) * rstd * (j < 4 ? gb0[j & 3] : gb1[j & 3]);
        const float cs = (j < 4 ? c0[j & 3] : c1[j & 3]), sn = (j < 4 ? s0[j & 3] : s1[j & 3]);
        y1[j] = x1 * cs - x2 * sn; y2[j] = x1 * sn + x2 * cs; }
      u32x4 w1, w2;
      w1.x = cvt_pk_bf16(y1[0], y1[1]); w1.y = cvt_pk_bf16(y1[2], y1[3]); w1.z = cvt_pk_bf16(y1[4], y1[5]); w1.w = cvt_pk_bf16(y1[6], y1[7]);
      w2.x = cvt_pk_bf16(y2[0], y2[1]); w2.y = cvt_pk_bf16(y2[2], y2[3]); w2.z = cvt_pk_bf16(y2[4], y2[5]); w2.w = cvt_pk_bf16(y2[6], y2[7]);
      qr[8 + 2 * part] = *reinterpret_cast<bf16x8*>(&w1); qr[9 + 2 * part] = *reinterpret_cast<bf16x8*>(&w2); }
  }
  { float z_ = 0.f; asm volatile("" : "+v"(z_));
#pragma unroll
    for (int d_ = 0; d_ < 4; ++d_)
#pragma unroll
      for (int r_ = 0; r_ < 16; ++r_) o[d_][r_] = z_; }
  constexpr int NT = NKEY / KVBLK;
#define RESC(a) do { if (__any((a) < 1.f)) { if (hi == 0) al_l[r32] = (a); asm volatile("s_waitcnt lgkmcnt(0)" ::: "memory"); \
    _Pragma("unroll") for (int d_ = 0; d_ < 4; ++d_) _Pragma("unroll") for (int r_ = 0; r_ < 16; ++r_) o[d_][r_] *= al_l[crow(r_, hi)]; } } while (0)
  f32x16 pA0, pA1, pB0, pB1; float mnA, mnB, alA, alB; bf16x8 pa0, pa1, pa2, pa3;
  DMA_WAIT(); __syncthreads();
  DMA_TILE(KVBLK, 1, 1);
  if (APROBE != 3) qkt(pA0, pA1, K_lds, qr, r32, hi); else { pA0 = f32x16{}; pA1 = f32x16{}; } if (APROBE != 1) partialSM(pA0, pA1, m_reg, mnA, alA); else { mnA = 0.f; alA = 1.f; }
  DMA_WAIT(); __syncthreads();
  int vprev = 0, vcur = 1, vnext = 2;
  for (int j = 1; j + 1 < NT; j += 2) {
    DMA_TILE((j + 1) * KVBLK, 0, vnext);
    SBAR(); if (APROBE != 3) qkt(pB0, pB1, K_lds + SHM_K, qr, r32, hi); else { pB0 = f32x16{}; pB1 = f32x16{}; }
    if (APROBE != 1) finishSM(pA0, pA1, alA, l_reg, pa0, pa1, pa2, pa3); else { pa0 = __builtin_bit_cast(bf16x8, (f32x4){pA0[0], pA0[1], pA1[0], pA1[1]}); pa1 = pa0; pa2 = pa0; pa3 = pa0; l_reg += 1.f; } SBAR();
    if (APROBE != 2) pv_d0(o, vb0 + vprev * SHM_V, pa0, pa1, pa2, pa3); if (APROBE != 1) partialSM(pB0, pB1, m_reg, mnB, alB); else { mnB = 0.f; alB = 1.f; }
    DMA_WAIT(); __syncthreads();
    RESC(alB);
    { const int t_ = vprev; vprev = vcur; vcur = vnext; vnext = t_; }
    DMA_TILE((j + 2) * KVBLK, 1, vnext);
    SBAR(); if (APROBE != 3) qkt(pA0, pA1, K_lds, qr, r32, hi); else { pA0 = f32x16{}; pA1 = f32x16{}; }
    if (APROBE != 1) finishSM(pB0, pB1, alB, l_reg, pa0, pa1, pa2, pa3); else { pa0 = __builtin_bit_cast(bf16x8, (f32x4){pB0[0], pB0[1], pB1[0], pB1[1]}); pa1 = pa0; pa2 = pa0; pa3 = pa0; l_reg += 1.f; } SBAR();
    if (APROBE != 2) pv_d0(o, vb0 + vprev * SHM_V, pa0, pa1, pa2, pa3); if (APROBE != 1) partialSM(pA0, pA1, m_reg, mnA, alA); else { mnA = 0.f; alA = 1.f; }
    DMA_WAIT(); __syncthreads();
    RESC(alA);
    { const int t_ = vprev; vprev = vcur; vcur = vnext; vnext = t_; }
  }
  SBAR(); if (APROBE != 3) qkt(pB0, pB1, K_lds + SHM_K, qr, r32, hi); else { pB0 = f32x16{}; pB1 = f32x16{}; }
  if (APROBE != 1) finishSM(pA0, pA1, alA, l_reg, pa0, pa1, pa2, pa3); else { pa0 = __builtin_bit_cast(bf16x8, (f32x4){pA0[0], pA0[1], pA1[0], pA1[1]}); pa1 = pa0; pa2 = pa0; pa3 = pa0; l_reg += 1.f; } SBAR();
  if (APROBE != 2) pv_d0(o, vb0 + vprev * SHM_V, pa0, pa1, pa2, pa3); if (APROBE != 1) partialSM(pB0, pB1, m_reg, mnB, alB); else { mnB = 0.f; alB = 1.f; }
  RESC(alB);
  if (APROBE != 1) finishSM(pB0, pB1, alB, l_reg, pa0, pa1, pa2, pa3); else { pa0 = __builtin_bit_cast(bf16x8, (f32x4){pB0[0], pB0[1], pB1[0], pB1[1]}); pa1 = pa0; pa2 = pa0; pa3 = pa0; l_reg += 1.f; } SBAR();
  if (APROBE != 2) pv_d0(o, vb0 + vcur * SHM_V, pa0, pa1, pa2, pa3);
#undef RESC
  if (hi == 0) li_l[r32] = l_reg; asm volatile("s_waitcnt lgkmcnt(0)" ::: "memory");
  bf16_t* Ow = Ob + (size_t)(wid * QBLK + 4 * hi) * 4096 + r32;
  asm volatile("" : "+v"(Ow));
#pragma unroll
  for (int r = 0; r < 16; ++r) { const int orow = crow(r, hi); const float rl = __builtin_amdgcn_rcpf(li_l[orow]);
#pragma unroll
    for (int d0 = 0; d0 < 4; ++d0) {
#ifdef DBG_ZERO_MLA
      Ow[(size_t)((r & 3) + 8 * (r >> 2)) * 4096 + d0 * 32] = 0;
#else
      if (APROBE == 0) Ow[(size_t)((r & 3) + 8 * (r >> 2)) * 4096 + d0 * 32] = f2bf(o[d0][r] * rl);
      else if (o[d0][r] * rl == 12345.678f) Ow[0] = 0;
#endif
    } }
  __syncthreads();
#undef DMA_TILE
#undef DMA_WAIT
}
#undef KSWZ
#undef SBAR
}

template <int APROBE> __device__ __forceinline__ void phase6_attn(const Params& P, const Ctx& C) {
    const bf16_t* QRAW = (const bf16_t*)(P.ws + WS_QRAW); const bf16_t* KM = (const bf16_t*)(P.ws + WS_KM); const bf16_t* VM = (const bf16_t*)(P.ws + WS_VM); bf16_t* YC = (bf16_t*)(P.ws + WS_YCAT);
    const int G = gridDim.x, c = blockIdx.x;
    for (int i = 0;; ++i) {
        int bh, qb;
        if (G == 256) { if (i >= 4) break; const int x = c & 7, jx = c >> 3; bh = x * 8 + i * 2 + (jx >> 4); qb = jx & 15; }
        else { const int U = i * G + c; if (U >= 1024) break; bh = U >> 4; qb = U & 15; }
        const int b = bh >> 4, h = bh & 15;
        attn::attn_unit<APROBE>(QRAW + (size_t)(b * 4096 + qb * 256) * 3072 + h * 192, KM + (size_t)bh * NKEY * 192, VM + (size_t)bh * NKEY * 128,
                        YC + (size_t)(b * 4096 + qb * 256) * 4096 + 2048 + h * 128, qb * 256, P.q_norm_g, (const float*)(P.ws + WS_ROPE), C.lds);
    }
}
constexpr int CONV_P9 = 16384;
__device__ __forceinline__ void expert_conv(const Params& P, const Ctx& C, const int it_lo, const int it_hi) {
    unsigned char* ws = P.ws;
    __syncthreads();
    LAS float* scr = (LAS float*)(C.lds + C.wave * 16384);
    bf16_t* WGU = (bf16_t*)(ws + WS_WGU); bf16_t* WD = (bf16_t*)(ws + WS_WD);
    auto ex_item = [&](int it) -> TrItem { const int e = it / 1536, r = it % 1536;
        if (r < 1024) { const int up = r >> 9, q = r & 511, kb = q >> 4, nb = q & 15, n0 = 32 * nb;
            const float* W = (up ? P.w_eu : P.w_eg) + (size_t)e * 2048 * 512;
            const int drow = (n0 >> 7) * 256 + up * 128 + (n0 & 127);
            return TrItem{W, 512, 64 * kb, n0, WGU + ((size_t)e * 1024 + drow) * 2048 + 64 * kb, 2048}; }
        const int q = r - 1024, kb = q >> 6, nb = q & 63;
        return TrItem{P.w_ed + (size_t)e * 512 * 2048, 2048, 64 * kb, 32 * nb, WD + ((size_t)e * 2048 + 32 * nb) * 512 + 64 * kb, 512}; };
    const int it0 = it_lo + C.wave, it_st = 8;
    if (it0 < it_hi) {
        f32x4 va[8], vb[8]; TrItem ta = ex_item(it0), tb = ta; tr_load(va, ta, C.lane);
        for (int it = it0; it < it_hi; it += 2 * it_st) {
            const bool hb = it + it_st < it_hi; if (hb) { tb = ex_item(it + it_st); tr_load(vb, tb, C.lane); }
            tr_store(va, ta, scr, C.lane);
            if (!hb) break;
            const bool ha = it + 2 * it_st < it_hi; if (ha) { ta = ex_item(it + 2 * it_st); tr_load(va, ta, C.lane); }
            tr_store(vb, tb, scr, C.lane);
        }
    }
    __syncthreads();
}
constexpr int RB_LD = 136;
__device__ __forceinline__ void phase9_router(const Params& P, const Ctx& C, const int mode9, const bool dry) {
    unsigned char* ws = P.ws;
    if (mode9 & 2) {
        const float* XM = P.out; const float* MOD = (const float*)(ws + WS_MOD);
        const bf16_t* WH = (const bf16_t*)(ws + WS_WRT);
        int* RTE = (int*)(ws + WS_ROUTE + RT_E); int* RTP = (int*)(ws + WS_ROUTE + RT_P); float* RTW = (float*)(ws + WS_ROUTE + RT_W);
        unsigned* CNT = (unsigned*)(ws + WS_CTL) + CW_CNT; bf16_t* H2 = (bf16_t*)(ws + WS_H2S);
        LAS bf16_t* Bs = (LAS bf16_t*)C.lds;
        LAS float* LG = (LAS float*)(C.lds + 87040) + C.wave * 1280;
        const int r = C.lane & 15, kq = C.lane >> 4;
        const bool xsplit = (gridDim.x == 256);
        for (int pass = xsplit ? (((int)blockIdx.x & 7) < 4 ? ((int)blockIdx.x >> 3) * 4 + ((int)blockIdx.x & 7) : TL) : (int)blockIdx.x; pass < TL / 128; pass += xsplit ? TL : (int)gridDim.x) {
            const int t = pass * 128 + C.wave * 16 + r, b = (pass * 128) >> 12;
            const float* xr = XM + (size_t)t * 2048 + 8 * kq;
            float ss;
            { const float* ps = (const float*)(ws + WS_PS) + (size_t)t * 32 + 8 * kq; const f32x4 a = *(const f32x4*)ps, c2 = *(const f32x4*)(ps + 4);
              ss = ((a[0] + a[1]) + (a[2] + a[3])) + ((c2[0] + c2[1]) + (c2[2] + c2[3])); }
            ss += __shfl_xor(ss, 16); ss += __shfl_xor(ss, 32);
            const float rstd = 1.f / sqrtf(ss * (1.f / 2048.f) + EPSN);
            LAS float* A2s = (LAS float*)(C.lds + 128000); LAS float* B2s = A2s + 2048;
            { const float* sc2 = MOD + (size_t)b * 12288 + 8192; const float* sh2 = MOD + (size_t)b * 12288 + 6144;
              const f32x4 gv = ((const f32x4*)P.norm2_g)[C.tid], cv = ((const f32x4*)sc2)[C.tid], sv = ((const f32x4*)sh2)[C.tid];
              ((LAS f32x4*)A2s)[C.tid] = gv * (cv + 1.f); ((LAS f32x4*)B2s)[C.tid] = sv; }
            f32x4 acc[5];
#pragma unroll
            for (int n = 0; n < 5; ++n) acc[n] = (f32x4){0.f, 0.f, 0.f, 0.f};
            u32x4 wreg[5]; f32x4 xA[4], xB[4];
#define RB_LOAD(ch) do { _Pragma("unroll") for (int i_ = 0; i_ < 5; ++i_) { const int p_ = C.tid + 512 * i_, wh_ = p_ / 1280, rem_ = p_ % 1280; \
                wreg[i_] = *(const u32x4*)(WH + (size_t)wh_ * (80 * 2048) + (size_t)(rem_ >> 4) * 2048 + 128 * (ch) + (rem_ & 15) * 8); } } while (0)
#define RX_LOAD(X, ch, part) do { _Pragma("unroll") for (int i_ = 0; i_ < 4; ++i_) X[i_] = *(const f32x4*)(xr + 128 * (ch) + 64 * (part) + 32 * (i_ >> 1) + 4 * (i_ & 1)); } while (0)
#define RB_STEP(X, xi, ch, s4) do { \
                    const int ko = 128 * (ch) + 32 * (s4) + 8 * kq; \
                    float hv[8]; \
                    _Pragma("unroll") for (int q = 0; q < 2; ++q) { const f32x4 av = *(const LAS f32x4*)(A2s + ko + 4 * q), bv = *(const LAS f32x4*)(B2s + ko + 4 * q); \
                        const f32x4 y = X[2 * (xi) + q] * rstd * av + bv; hv[4 * q] = y[0]; hv[4 * q + 1] = y[1]; hv[4 * q + 2] = y[2]; hv[4 * q + 3] = y[3]; } \
                    u32x4 wh, wl; \
                    _Pragma("unroll") for (int q = 0; q < 4; ++q) { const unsigned ph = cvt_pk_bf16(hv[2 * q], hv[2 * q + 1]); wh[q] = ph; wl[q] = cvt_pk_bf16(hv[2 * q] - bf_lo(ph), hv[2 * q + 1] - bf_hi(ph)); } \
                    if (!dry) *(u32x4*)(H2 + (size_t)t * 2048 + ko) = wh;        \
                    const bf16x8 ahi = *reinterpret_cast<bf16x8*>(&wh), alo = *reinterpret_cast<bf16x8*>(&wl); \
                    _Pragma("unroll") for (int n = 0; n < 5; ++n) { const LAS bf16_t* bp = Bb + (16 * n + r) * RB_LD + 32 * (s4) + 8 * kq; \
                        const bf16x8 bh = *(const LAS bf16x8*)bp, bl = *(const LAS bf16x8*)(bp + 80 * RB_LD); \
                        acc[n] = __builtin_amdgcn_mfma_f32_16x16x32_bf16(bh, ahi, acc[n], 0, 0, 0); \
                        acc[n] = __builtin_amdgcn_mfma_f32_16x16x32_bf16(bl, ahi, acc[n], 0, 0, 0); \
                        acc[n] = __builtin_amdgcn_mfma_f32_16x16x32_bf16(bh, alo, acc[n], 0, 0, 0); } \
                } while (0)
            RB_LOAD(0); RX_LOAD(xA, 0, 0); RX_LOAD(xB, 0, 1);
            for (int ch = 0; ch < 16; ++ch) {
                LAS bf16_t* Bb = Bs + (ch & 1) * (2 * 80 * RB_LD);
#pragma unroll
                for (int i = 0; i < 5; ++i) { const int p_ = C.tid + 512 * i, wh_ = p_ / 1280, rem_ = p_ % 1280;
                    *(LAS u32x4*)(Bb + (wh_ * 80 + (rem_ >> 4)) * RB_LD + (rem_ & 15) * 8) = wreg[i]; }
                __syncthreads();
                if (ch + 1 < 16) RB_LOAD(ch + 1);
                RB_STEP(xA, 0, ch, 0); __builtin_amdgcn_sched_barrier(0); RB_STEP(xA, 1, ch, 1); __builtin_amdgcn_sched_barrier(0);
                if (ch + 1 < 16) RX_LOAD(xA, ch + 1, 0);
                RB_STEP(xB, 0, ch, 2); __builtin_amdgcn_sched_barrier(0); RB_STEP(xB, 1, ch, 3); __builtin_amdgcn_sched_barrier(0);
                if (ch + 1 < 16) RX_LOAD(xB, ch + 1, 1);
            }
#undef RB_LOAD
#undef RX_LOAD
#undef RB_STEP
#pragma unroll
            for (int n = 0; n < 5; ++n) *(LAS f32x4*)(LG + r * 80 + 16 * n + 4 * kq) = acc[n];
            LDS_WAIT(); asm volatile("" ::: "memory");
            if (C.lane < 16 && !dry) {
                const LAS float* lg = LG + C.lane * 80;
                float gm = -3.0e38f; int gi = 0; float gl[8];
#pragma unroll
                for (int j = 0; j < 8; ++j) { gl[j] = lg[j] + P.b_rg[j]; if (gl[j] > gm) { gm = gl[j]; gi = j; } }
                float gs = 0.f;
#pragma unroll
                for (int j = 0; j < 8; ++j) gs += expf(gl[j] - gm);
                const float pg = 1.f / gs;
                float b1 = -3.0e38f, b2 = -3.0e38f; int i1 = 0, i2 = 0;
#pragma unroll
                for (int j = 0; j < 8; ++j) { const float v = lg[8 + gi * 8 + j] + P.b_re[gi * 8 + j];
                    if (v > b1) { b2 = b1; i2 = i1; b1 = v; i1 = j; } else if (v > b2) { b2 = v; i2 = j; } }
                const float e2 = expf(b2 - b1), w1 = pg / (1.f + e2), w2 = pg * e2 / (1.f + e2);
                const int ea = gi * 8 + i1, eb = gi * 8 + i2;
                const int pa = (int)__hip_atomic_fetch_add(CNT + ea, 1u, __ATOMIC_RELAXED, __HIP_MEMORY_SCOPE_AGENT);
                const int pb = (int)__hip_atomic_fetch_add(CNT + 64 + eb, 1u, __ATOMIC_RELAXED, __HIP_MEMORY_SCOPE_AGENT);
                RTE[2 * t] = ea; RTE[2 * t + 1] = eb; RTP[2 * t] = pa; RTP[2 * t + 1] = pb; RTW[2 * t] = w1; RTW[2 * t + 1] = w2;
            }
            __syncthreads();
        }
    }
    if (mode9 & 1) {
        { int* ROWTOK = (int*)(ws + WS_ROUTE + RT_ROWTOK); for (int i = blockIdx.x * 512 + C.tid; i < MOE_ROWS; i += gridDim.x * 512) ROWTOK[i] = -1; }
        __syncthreads();
        if (gridDim.x == 256 && (blockIdx.x & 7) >= 4) { const int clo = (((int)blockIdx.x >> 3) * 4 + ((int)blockIdx.x & 7) - 4) * (CONV_P9 / 128); expert_conv(P, C, clo, clo + CONV_P9 / 128); }
    }
}
template <bool WANT_BASE> __device__ __forceinline__ void moe_tables(const Params& P, const Ctx& C, LAS int* base, LAS int* tab) {
    const unsigned* CNT = (const unsigned*)(P.ws + WS_CTL) + CW_CNT;
    LAS int* cs = WANT_BASE ? base + 128 : tab + 300;
    if (C.tid < 128) cs[C.tid] = (int)CNT[C.tid];
    __syncthreads();
    if (C.tid < 128) { int start = 0;
#pragma unroll
        for (int g4 = 0; g4 < 32; ++g4) { const u32x4 v = *(const LAS u32x4*)(cs + 4 * g4);
#pragma unroll
            for (int q = 0; q < 4; ++q) start += (4 * g4 + q < C.tid) ? (int)((v[q] + 255u) >> 8) : 0; }
        const int cnt_ = cs[C.tid], nt = (cnt_ + 255) >> 8;
        if constexpr (WANT_BASE) base[C.tid] = start * 256;
        else { for (int j = 0; j < nt; ++j) tab[4 + start + j] = (C.tid & 63) | ((cnt_ - 256 * j <= 128) ? 64 : 0);
               if (C.tid == 63) tab[1] = start + nt; if (C.tid == 127) tab[0] = start + nt; } }
    __syncthreads();
}
__device__ __forceinline__ void phase10_dispatch(const Params& P, const Ctx& C) {
    unsigned char* ws = P.ws;
    LAS int* base = (LAS int*)C.lds;
    moe_tables<true>(P, C, base, base);
    const int* RTE = (const int*)(ws + WS_ROUTE + RT_E); const int* RTP = (const int*)(ws + WS_ROUTE + RT_P); const float* RTW = (const float*)(ws + WS_ROUTE + RT_W);
    int* ROWTOK = (int*)(ws + WS_ROUTE + RT_ROWTOK); float* ROWW = (float*)(ws + WS_ROUTE + RT_ROWW);
    for (int t = blockIdx.x * 512 + C.tid; t < TL; t += gridDim.x * 512) {
        const int r0 = base[RTE[2 * t] & 63] + RTP[2 * t], r1 = base[64 + (RTE[2 * t + 1] & 63)] + RTP[2 * t + 1];
        ROWTOK[r0] = t; ROWW[r0] = RTW[2 * t]; ROWTOK[r1] = t; ROWW[r1] = RTW[2 * t + 1];
    }
}

constexpr int N_PHASES = 14;
__global__ void __launch_bounds__(512, 2) mega_fwd(Params PK) {
    extern __shared__ __attribute__((aligned(16))) unsigned char lds_raw[];
#if defined(__HIP_DEVICE_COMPILE__)
#define KARGS(p_) (*(p_))
#else
#define KARGS(p_) (PK)
#endif
#define MKCTX() const __attribute__((address_space(4))) Params* pk_ = (const __attribute__((address_space(4))) Params*)__builtin_amdgcn_kernarg_segment_ptr(); \
    asm volatile("" : "+s"(pk_)); const Params P = KARGS(pk_); unsigned char* const ws = P.ws; Ctx C; { int t_ = threadIdx.x; asm volatile("" : "+v"(t_)); C.lds = (LAS unsigned char*)lds_raw; C.tid = t_; C.lane = t_ & 63; C.wave = __builtin_amdgcn_readfirstlane(t_ >> 6); C.gw = blockIdx.x * 8 + C.wave; C.ngw = gridDim.x * 8; }
    LAS unsigned char* const lds0 = (LAS unsigned char*)lds_raw;
    unsigned char* const ws0 = PK.ws;
    for (int u = threadIdx.x; u < (LDS_BYTES - LDS_CTL_OFF) / 4; u += 512) ((LAS unsigned*)(lds0 + LDS_CTL_OFF))[u] = 0u;
    __syncthreads();
    const int lo = PK.ph_lo, hi = PK.ph_hi;
    XcdBarrier bar; bar.bar = (unsigned*)(ws0 + WS_CTL) + CW_BAR; bar.x = 0; bar.st = nullptr;
    if (hi - lo > 1) bar = xcd_barrier_post((unsigned*)(ws0 + WS_CTL) + CW_BAR, (volatile LAS unsigned*)(lds0 + LDS_CTL_OFF));
#ifndef PH_MASK
#define PH_MASK 0x3fff
#endif
#define IN(k) (((PH_MASK >> (k)) & 1) && lo <= (k) && (k) < hi)
#define SEAM(k) do { if (IN(k) && IN((k) + 1)) xcd_barrier(bar); } while (0)
#ifndef REP_MASK
#define REP_MASK 0
#endif
#define REPEAT(k) for (int rep_ = 0; rep_ < 1 + ((REP_MASK >> (k)) & 1); ++rep_)
#define REPSYNC() do { if (rep_) xcd_barrier(bar); } while (0)
    const int G = gridDim.x, cb = blockIdx.x;

    if (IN(0)) REPEAT(0) { REPSYNC(); MKCTX(); phase0(P, C); } SEAM(0);
    if (IN(1)) REPEAT(1) { REPSYNC(); MKCTX(); phase1(P, C); } SEAM(1);
    if (IN(2)) REPEAT(2) { REPSYNC(); MKCTX();
        pg8::DenseOrder S; S.init((const bf16_t*)(ws + WS_H), (const bf16_t*)(ws + WS_WIN), TA, N_INP, 2048, 2048, G, cb);
        EpiProj E{(bf16_t*)(ws + WS_QK), (bf16_t*)(ws + WS_V), (bf16_t*)(ws + WS_R), (bf16_t*)(ws + WS_GAB), (float*)(ws + WS_SM)};
        pg8::gemm_phase<EpiProj, pg8::DenseOrder, true>(C.lds, pg8::Gemm{2048, 2048, 2048}, S, E);
    } SEAM(2);
    if (IN(3)) REPEAT(3) { REPSYNC(); MKCTX(); phase3_tok(P, C); phase3_gla(P, C); } SEAM(3);
    if (IN(4)) REPEAT(4) { REPSYNC(); MKCTX();
#ifndef DBG_NO_UQKV
        {
            pg8::DenseOrder S; S.init((const bf16_t*)(ws + WS_CQN), (const bf16_t*)(ws + WS_WUQ), TL, 3072, 512, 512, G, cb);
            EpiPlain E{(bf16_t*)(ws + WS_QRAW), 3072};
            pg8::gemm_phase<EpiPlain, pg8::DenseOrder, true>(C.lds, pg8::Gemm{512, 512, 512}, S, E);
        }
        {
            pg8::DenseOrder S; S.init((const bf16_t*)(ws + WS_CKVN), (const bf16_t*)(ws + WS_WUKV), TA, 4096, 512, 512, G, cb);
            EpiUkv E{(bf16_t*)(ws + WS_KM), (bf16_t*)(ws + WS_VM), (const float*)(ws + WS_SSKR), (float*)(ws + WS_RSTD), P.k_norm_g, (LAS float*)(C.lds + 131072)};
            pg8::gemm_phase<EpiUkv, pg8::DenseOrder, true>(C.lds, pg8::Gemm{512, 512, 512}, S, E);
        }
#endif
        phase4_scan(P, C);
#if (REP_MASK >> 15) & 1
        phase4_scan(P, C);
#endif
    } SEAM(4);
    if (IN(5)) REPEAT(5) { REPSYNC(); MKCTX(); phase5_kprep(P, C); phase5_readout(P, C); } SEAM(5);
#ifndef APROBE_MODE
#define APROBE_MODE 0
#endif
    if (IN(6)) { { MKCTX(); phase6_attn<0>(P, C); }
#if (REP_MASK >> 6) & 1
        { xcd_barrier(bar); MKCTX(); phase6_attn<APROBE_MODE>(P, C); }
#endif
    } SEAM(6);
    if (IN(7)) REPEAT(7) { REPSYNC(); MKCTX();
        pg8::DualOrder S; S.D.init((const bf16_t*)(ws + WS_YCAT), (const bf16_t*)(ws + WS_WCAT), TL, 2048, 4096, 4096, G, cb); S.koff = (size_t)2048 * 2;
        EpiMerge E{(const bf16_t*)(ws + WS_GAB), (bf16_t*)(ws + WS_Y)};
#pragma nounroll
        for (int stage = 0; stage < 3; ++stage) {
            if ((((int)blockIdx.x & 7) % 3) == stage) {
                const int g_ = (int)gridDim.x, base = (g_ == 256) ? CONV_P9 : 0, cper = (64 * 1536 - base + g_ - 1) / g_, clo = base + (int)blockIdx.x * cper;
                expert_conv(P, C, clo, (clo + cper < 64 * 1536) ? clo + cper : 64 * 1536); }
            if (stage == 2) break;
            S.r0 = stage; S.r1 = stage ? (1 << 30) : 1;
            pg8::gemm_phase<EpiMerge, pg8::DualOrder, true>(C.lds, pg8::Gemm{4096, 4096, 2048}, S, E);
        }
    } SEAM(7);
    if (IN(8)) REPEAT(8) { REPSYNC(); MKCTX();
        pg8::DenseOrder S; S.init((const bf16_t*)(ws + WS_Y), (const bf16_t*)(ws + WS_WOUT), TL, 2048, 2048, 2048, G, cb);
        EpiOut E{P.x, (const float*)(ws + WS_MOD), P.out, (float*)(ws + WS_PS)};
        pg8::gemm_phase<EpiOut, pg8::DenseOrder, true>(C.lds, pg8::Gemm{2048, 2048, 2048}, S, E);
    } SEAM(8);
    if (IN(9)) { { MKCTX(); phase9_router(P, C, 3, false); }
#if (REP_MASK >> 13) & 1
        { xcd_barrier(bar); MKCTX(); phase9_router(P, C, 1, false); }
#endif
#if (REP_MASK >> 14) & 1
        { xcd_barrier(bar); MKCTX(); phase9_router(P, C, 2, true); }
#endif
    } SEAM(9);
    if (IN(10)) REPEAT(10) { REPSYNC(); MKCTX(); phase10_dispatch(P, C); } SEAM(10);
    if (IN(11)) REPEAT(11) { REPSYNC(); MKCTX();
        LAS int* tab = (LAS int*)(C.lds + LDS_MOE_OFF);
        moe_tables<false>(P, C, tab, tab);
        pg8::MoeOrder S; S.tile0 = 0; S.ntiles = tab[0]; S.nN = 4; S.G = G; S.c = cb; S.A = (const char*)(ws + WS_H2S); S.B = (const char*)(ws + WS_WGU);
        S.tA = 0; S.tB = (size_t)256 * 2048 * 2; S.eB = (size_t)1024 * 2048 * 2; S.tile_e = tab + 4; S.rowtok = (const int*)(ws + WS_ROUTE + RT_ROWTOK);
        EpiGU E{(bf16_t*)(ws + WS_ACT)};
        pg8::gemm_phase<EpiGU, pg8::MoeOrder, true, true>(C.lds, pg8::Gemm{2048, 2048, 2048}, S, E);
    } SEAM(11);
    if (IN(12)) { MKCTX();
        LAS int* tab = (LAS int*)(C.lds + LDS_MOE_OFF);
        moe_tables<false>(P, C, tab, tab);
        pg8::MoeOrder S; S.tile0 = 0; S.ntiles = tab[1]; S.nN = 8; S.G = G; S.c = cb; S.A = (const char*)(ws + WS_ACT); S.B = (const char*)(ws + WS_WD);
        S.tA = (size_t)256 * 512 * 2; S.tB = (size_t)256 * 512 * 2; S.eB = (size_t)2048 * 512 * 2; S.tile_e = tab + 4; S.rowtok = nullptr;
        EpiDown E{(const int*)(ws + WS_ROUTE + RT_ROWTOK), (const float*)(ws + WS_ROUTE + RT_ROWW), (const float*)(ws + WS_MOD), P.out};
        pg8::gemm_phase<EpiDown, pg8::MoeOrder, true>(C.lds, pg8::Gemm{512, 512, 512}, S, E);
    } SEAM(12);
    if (IN(13)) { MKCTX();
        LAS int* tab = (LAS int*)(C.lds + LDS_MOE_OFF);
        moe_tables<false>(P, C, tab, tab);
        pg8::MoeOrder S; S.tile0 = tab[1]; S.ntiles = tab[0] - tab[1]; S.nN = 8; S.G = G; S.c = cb; S.A = (const char*)(ws + WS_ACT); S.B = (const char*)(ws + WS_WD);
        S.tA = (size_t)256 * 512 * 2; S.tB = (size_t)256 * 512 * 2; S.eB = (size_t)2048 * 512 * 2; S.tile_e = tab + 4; S.rowtok = nullptr;
        EpiDown E{(const int*)(ws + WS_ROUTE + RT_ROWTOK), (const float*)(ws + WS_ROUTE + RT_ROWW), (const float*)(ws + WS_MOD), P.out};
        pg8::gemm_phase<EpiDown, pg8::MoeOrder, true>(C.lds, pg8::Gemm{512, 512, 512}, S, E);
    }
#undef IN
#undef SEAM
}

#ifdef DBG_BUF_OFF
__global__ void dbg_out(const float* x, const unsigned char* ws, float* out) {
    const bf16_t* buf = (const bf16_t*)(ws + (size_t)DBG_BUF_OFF);
    for (size_t i = (size_t)blockIdx.x * 256 + threadIdx.x; i < (size_t)TL * 2048; i += (size_t)gridDim.x * 256) {
        const size_t t = i >> 11, c = i & 2047;
#if defined(DBG_I32)
        out[i] = x[i] + (float)((const int*)buf)[t * DBG_LD + DBG_COL + (c % DBG_W)] * DBG_I32;
#elif defined(DBG_F32)
        out[i] = x[i] + ((const float*)buf)[t * DBG_LD + DBG_COL + (c % DBG_W)];
#else
        { float v_ = bf2f(buf[t * DBG_LD + DBG_COL + (c % DBG_W)]);
#ifdef DBG_SCRUB
          if (!(fabsf(v_) < 1e30f)) v_ = 1000.f;
#endif
          out[i] = x[i] + v_; }
#endif
    }
}
#endif
#ifndef MK_SPLIT
#define MK_SPLIT 0
#endif
extern "C" void kernel_launch(void* const* d_in, const int* in_sizes, int n_in, void* d_out, int out_size, void* d_ws, size_t ws_size, hipStream_t stream) {
    static int grid = 0;
    if (grid == 0) {
        if (n_in != 30 || in_sizes[0] != TL * DM || out_size != TL * DM || ws_size < WS_END) { fprintf(stderr, "kernel_launch: shape/workspace mismatch (n_in %d, in0 %d, out %d, ws %zu < %zu)\n", n_in, n_in > 0 ? in_sizes[0] : -1, out_size, ws_size, (size_t)WS_END); grid = -1; return; }
        int dev = 0, cus = 0, per_cu = 0;
        if (hipGetDevice(&dev) != hipSuccess || hipDeviceGetAttribute(&cus, hipDeviceAttributeMultiprocessorCount, dev) != hipSuccess) { grid = -1; return; }
        if (hipFuncSetAttribute((const void*)mega_fwd, hipFuncAttributeMaxDynamicSharedMemorySize, LDS_BYTES) != hipSuccess) { fprintf(stderr, "kernel_launch: hipFuncSetAttribute failed\n"); grid = -1; return; }
        if (hipOccupancyMaxActiveBlocksPerMultiprocessor(&per_cu, (const void*)mega_fwd, 512, LDS_BYTES) != hipSuccess || per_cu < 1) fprintf(stderr, "kernel_launch: occupancy query says %d\n", per_cu);
        (void)hipGetLastError();
        grid = cus;
    }
    if (grid < 0) return;
    (void)hipMemsetAsync((char*)d_ws + WS_CTL, 0, CTL_ZERO_BYTES, stream);
    Params p{};
    const float** pf = (const float**)&p;
    for (int i = 0; i < 30; ++i) pf[i] = (const float*)d_in[i];
    p.out = (float*)d_out; p.ws = (unsigned char*)d_ws;
#if MK_SPLIT
#ifndef MK_LAST
#define MK_LAST 13
#endif
    for (int k = 0; k < MK_LAST; ++k) { p.ph_lo = k; p.ph_hi = k + 1; hipLaunchKernelGGL(mega_fwd, dim3(grid), dim3(512), LDS_BYTES, stream, p); }
#else
    p.ph_lo = 0; p.ph_hi = N_PHASES; hipLaunchKernelGGL(mega_fwd, dim3(grid), dim3(512), LDS_BYTES, stream, p);
#endif
#ifdef DBG_BUF_OFF
    hipLaunchKernelGGL(dbg_out, dim3(2048), dim3(256), 0, stream, (const float*)d_in[0], (const unsigned char*)d_ws, (float*)d_out);
#endif
    const hipError_t le = hipPeekAtLastError();
    if (le != hipSuccess) fprintf(stderr, "kernel_launch: launch failed: %s\n", hipGetErrorName(le));
}
```
